# Optimizing an MI355X kernel written in HIP

```python
import jax, jax.numpy as jnp
from jax import lax
import numpy as np

D_MODEL = 1024
BATCH = 4
SEQ = 8192
DEPTH = 1

HEAD_DIM = 64
FOX_HEADS = 8
SWA_HEADS = 8
SWA_KV_HEADS = 2
SWA_GROUP = SWA_HEADS // SWA_KV_HEADS
MIX_WIDTH = (FOX_HEADS + SWA_HEADS) * HEAD_DIM
Q_BLOCK = 128
WINDOW = 128
FOX_Q_W = FOX_HEADS * HEAD_DIM
FOX_K_W = FOX_HEADS * HEAD_DIM
FOX_V_W = FOX_HEADS * HEAD_DIM
FOX_F_W = FOX_HEADS
SWA_Q_W = SWA_HEADS * HEAD_DIM
SWA_K_W = SWA_KV_HEADS * HEAD_DIM
SWA_V_W = SWA_KV_HEADS * HEAD_DIM
IN_WIDTH = FOX_Q_W + FOX_K_W + FOX_V_W + FOX_F_W + SWA_Q_W + SWA_K_W + SWA_V_W
PEER_HEADS = 8
PEER_QUERY_DIM = 256
PEER_HALF = PEER_QUERY_DIM // 2
N_KEYS = 128
N_EXPERTS = N_KEYS * N_KEYS
PEER_TOPK = 16
PEER_CHUNK = 128
N_MOD = 6
RMS_EPS = 1e-6
NEG_INF = -1e30

kernel_name = "hymba_fox_swa_peer_block"


def rmsnorm(x, g):
    xf = x.astype(jnp.float32)
    y = xf * lax.rsqrt(jnp.mean(xf * xf, axis=-1, keepdims=True) + RMS_EPS)
    return y.astype(x.dtype) * g


def alibi_slopes(n):
    return jnp.exp2(-8.0 * jnp.arange(1, n + 1, dtype=jnp.float32) / n)


def fox_attention(q, k, v, f_logit):
    B, S, H, Dh = q.shape
    nb = S // Q_BLOCK
    F = jnp.cumsum(jax.nn.log_sigmoid(f_logit.astype(jnp.float32)), axis=1)
    Fk = F.transpose(0, 2, 1)
    kpos = jnp.arange(S)
    scale = Dh ** -0.5

    def block(i):
        start = i * Q_BLOCK
        qb = lax.dynamic_slice_in_dim(q, start, Q_BLOCK, axis=1)
        Fq = lax.dynamic_slice_in_dim(Fk, start, Q_BLOCK, axis=2)
        s = jnp.einsum('bqhd,bkhd->bhqk', qb, k).astype(jnp.float32) * scale
        s = s + Fq[..., :, None] - Fk[..., None, :]
        qpos = start + jnp.arange(Q_BLOCK)
        s = jnp.where(kpos[None, :] <= qpos[:, None], s, NEG_INF)
        p = jax.nn.softmax(s, axis=-1).astype(v.dtype)
        return jnp.einsum('bhqk,bkhd->bqhd', p, v)

    out = lax.map(block, jnp.arange(nb))
    return out.transpose(1, 0, 2, 3, 4).reshape(B, S, H * Dh)


def swa_attention(q, k, v, sinks):
    B, S = q.shape[0], q.shape[1]
    nb = S // WINDOW
    scale = HEAD_DIM ** -0.5
    qb = q.reshape(B, nb, WINDOW, SWA_KV_HEADS, SWA_GROUP, HEAD_DIM)

    def band(t):
        tp = jnp.pad(t, ((0, 0), (WINDOW, 0), (0, 0), (0, 0)))
        prev = tp[:, :S].reshape(B, nb, WINDOW, SWA_KV_HEADS, HEAD_DIM)
        cur = t.reshape(B, nb, WINDOW, SWA_KV_HEADS, HEAD_DIM)
        return jnp.concatenate([prev, cur], axis=2)

    kb, vb = band(k), band(v)
    s = jnp.einsum('bnqkgd,bnjkd->bnkgqj', qb, kb).astype(jnp.float32) * scale
    r = jnp.arange(WINDOW)[:, None]
    j = jnp.arange(2 * WINDOW)[None, :]
    dist = r + WINDOW - j
    valid = (dist >= 0) & (dist < WINDOW)
    not_pad = (jnp.arange(nb)[:, None] * WINDOW - WINDOW + jnp.arange(2 * WINDOW)[None, :]) >= 0
    mask = valid[None] & not_pad[:, None, :]
    slopes = alibi_slopes(SWA_HEADS).reshape(SWA_KV_HEADS, SWA_GROUP)
    s = s - slopes[:, :, None, None] * dist.astype(jnp.float32)
    s = jnp.where(mask[None, :, None, None], s, NEG_INF)
    sink = jnp.broadcast_to(sinks.astype(jnp.float32).reshape(SWA_KV_HEADS, SWA_GROUP, 1, 1),
                            s.shape[:-1] + (1,))
    p = jax.nn.softmax(jnp.concatenate([s, sink], axis=-1), axis=-1)[..., :-1]
    out = jnp.einsum('bnkgqj,bnjkd->bnqkgd', p.astype(v.dtype), vb)
    return out.reshape(B, S, SWA_HEADS * HEAD_DIM)


def peer_ffn(h, w_query, sub_keys, w_u, w_v):
    B, S, D = h.shape
    T = B * S
    hf = h.reshape(T, D)
    q = (hf @ w_query).reshape(T, PEER_HEADS, 2, PEER_HALF)
    sc = jnp.einsum('thpd,hpkd->thpk', q, sub_keys).astype(jnp.float32)
    sv, si = lax.top_k(sc, PEER_TOPK)
    cand = sv[:, :, 0, :, None] + sv[:, :, 1, None, :]
    cv, ci = lax.top_k(cand.reshape(T, PEER_HEADS, PEER_TOPK * PEER_TOPK), PEER_TOPK)
    i1 = jnp.take_along_axis(si[:, :, 0, :], ci // PEER_TOPK, axis=-1)
    i2 = jnp.take_along_axis(si[:, :, 1, :], ci % PEER_TOPK, axis=-1)
    experts = i1 * N_KEYS + i2
    gates = jax.nn.softmax(cv, axis=-1)
    nc = T // PEER_CHUNK
    experts = experts.reshape(nc, PEER_CHUNK, PEER_HEADS * PEER_TOPK)
    gates = gates.reshape(nc, PEER_CHUNK, PEER_HEADS * PEER_TOPK).astype(h.dtype)

    def chunk(args):
        hc, ec, gc = args
        u = jnp.take(w_u, ec, axis=0)
        a = jax.nn.gelu(jnp.einsum('cd,ced->ce', hc, u)) * gc
        vv = jnp.take(w_v, ec, axis=0)
        return jnp.einsum('ce,ced->cd', a, vv)

    out = lax.map(chunk, (hf.reshape(nc, PEER_CHUNK, D), experts, gates))
    return out.reshape(B, S, D)


def setup_inputs(seed: int = 0) -> dict:
    key = jax.random.key(seed)
    ks = jax.random.split(key, 16)
    D = D_MODEL
    nrm = jax.random.normal
    f32 = jnp.float32
    return {
        "x": nrm(ks[0], (BATCH, SEQ, D), f32),
        "c": nrm(ks[1], (BATCH, D), f32),
        "w_ada": nrm(ks[2], (DEPTH, D, N_MOD * D), f32) * (0.5 * D ** -0.5),
        "b_ada": nrm(ks[3], (DEPTH, N_MOD * D), f32) * 0.1,
        "g_pre_mix": 1.0 + 0.05 * nrm(ks[4], (DEPTH, D), f32),
        "g_post_mix": 1.0 + 0.05 * nrm(ks[5], (DEPTH, D), f32),
        "g_pre_ffn": 1.0 + 0.05 * nrm(ks[6], (DEPTH, D), f32),
        "g_post_ffn": 1.0 + 0.05 * nrm(ks[7], (DEPTH, D), f32),
        "w_in": nrm(ks[8], (DEPTH, D, IN_WIDTH), f32) * D ** -0.5,
        "b_fgate": 3.0 + 0.5 * nrm(ks[9], (DEPTH, FOX_HEADS), f32),
        "swa_sinks": 0.5 * nrm(ks[10], (DEPTH, SWA_HEADS), f32),
        "w_out": nrm(ks[11], (DEPTH, MIX_WIDTH, D), f32) * MIX_WIDTH ** -0.5,
        "w_query": nrm(ks[12], (DEPTH, D, PEER_HEADS * PEER_QUERY_DIM), f32) * D ** -0.5,
        "sub_keys": nrm(ks[13], (DEPTH, PEER_HEADS, 2, N_KEYS, PEER_HALF), f32) * PEER_HALF ** -0.5,
        "w_u": nrm(ks[14], (DEPTH, N_EXPERTS, D), f32) * D ** -0.5,
        "w_v": nrm(ks[15], (DEPTH, N_EXPERTS, D), f32) * D ** -0.5,
    }


def reference(x, c, w_ada, b_ada, g_pre_mix, g_post_mix, g_pre_ffn, g_post_ffn,
              w_in, b_fgate, swa_sinks, w_out, w_query, sub_keys, w_u, w_v):
    B, S, _ = x.shape
    s1 = FOX_Q_W
    s2 = s1 + FOX_K_W
    s3 = s2 + FOX_V_W
    s4 = s3 + FOX_F_W
    s5 = s4 + SWA_Q_W
    s6 = s5 + SWA_K_W
    for l in range(DEPTH):
        mod = jax.nn.silu(c) @ w_ada[l] + b_ada[l]
        sh1, sc1, gt1, sh2, sc2, gt2 = [m[:, None, :] for m in jnp.split(mod, N_MOD, axis=-1)]

        h = rmsnorm(x, g_pre_mix[l]) * (1 + sc1) + sh1
        proj = h @ w_in[l]
        fq, fk, fv, ff, sq, sk, sv = jnp.split(proj, [s1, s2, s3, s4, s5, s6], axis=-1)
        fox = fox_attention(fq.reshape(B, S, FOX_HEADS, HEAD_DIM),
                            fk.reshape(B, S, FOX_HEADS, HEAD_DIM),
                            fv.reshape(B, S, FOX_HEADS, HEAD_DIM),
                            ff + b_fgate[l])
        swa = swa_attention(sq.reshape(B, S, SWA_HEADS, HEAD_DIM),
                            sk.reshape(B, S, SWA_KV_HEADS, HEAD_DIM),
                            sv.reshape(B, S, SWA_KV_HEADS, HEAD_DIM),
                            swa_sinks[l])
        y = jnp.concatenate([fox, swa], axis=-1) @ w_out[l]
        x = x + gt1 * rmsnorm(y, g_post_mix[l])

        h = rmsnorm(x, g_pre_ffn[l]) * (1 + sc2) + sh2
        y = peer_ffn(h, w_query[l], sub_keys[l], w_u[l], w_v[l])
        x = x + gt2 * rmsnorm(y, g_post_ffn[l])
    return x
```

```cpp
#include <hip/hip_runtime.h>
#include <hip/hip_cooperative_groups.h>
#include <cstdio>
#include <cstdint>
namespace cg = cooperative_groups;

#define LAS __attribute__((address_space(3)))
typedef unsigned short bf16_t;
typedef short bf16x8 __attribute__((ext_vector_type(8)));
typedef short s16x4 __attribute__((ext_vector_type(4)));
typedef float f32x4 __attribute__((ext_vector_type(4)));
typedef float f32x16 __attribute__((ext_vector_type(16)));
typedef unsigned u32x4 __attribute__((ext_vector_type(4)));
typedef unsigned u32x2 __attribute__((ext_vector_type(2)));
typedef float f32x2_t __attribute__((ext_vector_type(2)));
typedef __bf16 bf16x2_t __attribute__((ext_vector_type(2)));

constexpr int BATCH = 4, SEQ = 8192, DM = 1024, T = BATCH * SEQ;
constexpr int NPROJ = 2304, INW = 2312;
constexpr int NMOD = 6 * DM;
constexpr float RMS_EPS = 1e-6f;
constexpr float LOG2E = 1.4426950408889634f;
constexpr float C2 = 0.125f * LOG2E;
constexpr float NEGBIG = -1e30f;

constexpr size_t MiB = 1u << 20;
constexpr size_t WS_MOD = 0, WS_WF = 128 * 1024, WS_KT = 256 * 1024  , WS_BAR = 512 * 1024  , WS_HMAX = 640 * 1024  , WS_LS = 1 * MiB, WS_KB = 2 * MiB;
constexpr size_t WS_WTIN = 4 * MiB, WS_WTOUT = 10 * MiB, WS_WTQ = 12 * MiB, WS_SK = 16 * MiB;
constexpr size_t WS_U8 = 32 * MiB, WS_V8 = 48 * MiB, WS_SU = 64 * MiB, WS_SV = 64 * MiB + 65536, WS_H = 96 * MiB, WS_ATT = 160 * MiB, WS_PROJ = 224 * MiB;
constexpr size_t WS_EIDX = 160 * MiB, WS_GATE = 176 * MiB  , WS_X1 = 352 * MiB, WS_END = 480 * MiB;

constexpr int NTHREADS = 512, NWAVES = 8;
#define REP_PHASE 0
#define REPEAT(k, ...) do { __VA_ARGS__; if (REP_PHASE == (k)) { __syncthreads(); __VA_ARGS__; } } while (0)
constexpr int LDS_BYTES = 163840;

__device__ __forceinline__ unsigned cvtpk(float lo, float hi) { f32x2_t v = {lo, hi}; bf16x2_t b = __builtin_convertvector(v, bf16x2_t); return __builtin_bit_cast(unsigned, b); }
__device__ __forceinline__ float bflo(unsigned w) { return __uint_as_float(w << 16); }
__device__ __forceinline__ float bfhi(unsigned w) { return __uint_as_float(w & 0xffff0000u); }
__device__ __forceinline__ float wave_sum(float v) {
#pragma unroll
    for (int o = 1; o < 64; o <<= 1) v += __shfl_xor(v, o);
    return v;
}
__device__ __forceinline__ float vmaxf(float a, float b) { float r; asm("v_max_f32_e32 %0, %1, %2" : "=v"(r) : "v"(a), "v"(b)); return r; }
__device__ __forceinline__ float vminf(float a, float b) { float r; asm("v_min_f32_e32 %0, %1, %2" : "=v"(r) : "v"(a), "v"(b)); return r; }
__device__ __forceinline__ int fresh_tid() { int t = threadIdx.x; asm volatile("" : "+v"(t)); return t; }
__device__ __forceinline__ int crow(int r, int hi) { return (r & 3) + 8 * (r >> 2) + 4 * hi; }

namespace pg8 {
constexpr int BM = 256, BK = 64, HALF = 128, HTB = HALF * BK * 2, STAGE_BYTES = 8 * HTB, NXCD = 8, WGM = 8;
__host__ __device__ __forceinline__ int lds_byte(int r, int c) { const int st = (r >> 4) * 2 + (c >> 5), rr = r & 15, cc = c & 31, ob = rr * 64 + cc * 2; return st * 1024 + (ob ^ (((ob >> 9) & 1) << 5)); }
__host__ __device__ __forceinline__ void stage_rc(int b, int& R, int& C) { const int st = b / 1024, sb = b % 1024, swz = sb ^ (((sb >> 9) & 1) << 5); R = (st >> 1) * 16 + swz / 64; C = (st & 1) * 32 + (swz % 64) / 2; }
__host__ __device__ __forceinline__ int perm32(int rho) { const int n = rho >> 4, i = rho & 15; return 8 * (i >> 2) + 4 * n + (i & 3); }
struct Unit { int pm, pn; };
struct Gemm { const bf16_t* A; const bf16_t* Bt; int M, N, K; };
struct StaticOrder {
    int nM, nN, nwg, G, c;
    __device__ void init(int M, int N, int G_, int c_) { nM = M / BM; nN = N / BM; nwg = nM * nN; G = G_; c = c_; }
    __device__ bool next(int i, Unit& u) const {
        const long L = (long)i * G + c; if (L >= nwg) return false;
        int wgid = (int)L; { const int q = nwg / NXCD, r = nwg % NXCD, xcd = wgid % NXCD, off = wgid / NXCD; wgid = (xcd < r ? xcd * (q + 1) : r * (q + 1) + (xcd - r) * q) + off; }
        const int nig = WGM * nN, gid = wgid / nig, fm = gid * WGM, gsz = (nM - fm) < WGM ? (nM - fm) : WGM;
        u.pm = fm + ((wgid % nig) % gsz); u.pn = (wgid % nig) / gsz; return true;
    }
};
struct EpiBf16 {
    static constexpr bool PERM = true;
    bf16_t* O; int ldc; unsigned scale_mask; float sc;
    __device__ __forceinline__ void operator()(const f32x4 (&acc)[2][2][4][2], const Unit& u, int wr, int wc, int fr, int fq) const {
        const int row0 = u.pm * BM + wr * 64 + fr; const int col0 = u.pn * BM + wc * 32 + 8 * fq;
        const float s = ((scale_mask >> u.pn) & 1u) ? sc : 1.f;
#pragma unroll
        for (int ai = 0; ai < 2; ++ai)
#pragma unroll
            for (int m = 0; m < 4; ++m) { bf16_t* rowp = O + (size_t)(row0 + ai * HALF + m * 16) * ldc + col0;
#pragma unroll
                for (int bj = 0; bj < 2; ++bj) { const f32x4 v0 = acc[ai][bj][m][0] * s, v1 = acc[ai][bj][m][1] * s;
                    u32x4 w; w.x = cvtpk(v0[0], v0[1]); w.y = cvtpk(v0[2], v0[3]); w.z = cvtpk(v1[0], v1[1]); w.w = cvtpk(v1[2], v1[3]);
                    *(u32x4*)(rowp + bj * HALF) = w; } }
    }
};

template <class Epi, class Sched>
__device__ __forceinline__ void gemm_phase(LAS unsigned char* lds, const Gemm g, const Sched& S, const Epi& E) {
    const int tid = fresh_tid(), wid = __builtin_amdgcn_readfirstlane(tid >> 6), lane = tid & 63, wr = wid >> 2, wc = wid & 3, fr = lane & 15, fq = lane >> 4;
    const int K = g.K, nt = K / BK;
    unsigned voffA[2], voffB[2];
#pragma unroll
    for (int i = 0; i < 2; ++i) { int R, C; stage_rc(tid * 16 + i * 8192, R, C); const int Rb = Epi::PERM ? ((R & ~31) + perm32(R & 31)) : R;
        voffA[i] = (unsigned)(R * K + C) * 2u; voffB[i] = (unsigned)(Rb * K + C) * 2u; }
    const size_t kstep = (size_t)(BK * 2);
    const size_t hstep = (size_t)HALF * K * 2;
    const size_t tstep = 2 * hstep;
    const unsigned ldsw = (unsigned)wid * 1024u;
    const int aoff = lds_byte(wr * 64 + fr, fq * 8), boff = lds_byte(wc * 32 + fr, fq * 8);
#define PG8_SA(b, h) (((b) * 2 + (h)) * HTB)
#define PG8_SB(b, h) ((4 + (b) * 2 + (h)) * HTB)
#define PG8_STAGE(bufoff, gbase, voff) do { _Pragma("unroll") for (int _i = 0; _i < 2; ++_i) \
        __builtin_amdgcn_global_load_lds((const unsigned*)((const char*)(gbase) + (voff)[_i]), (LAS unsigned*)(lds + (bufoff) + ldsw + _i * 8192), 16, 0, 0); } while (0)
#define PG8_LDA(dst, b, h) do { _Pragma("unroll") for (int m = 0; m < 4; ++m) _Pragma("unroll") for (int k = 0; k < 2; ++k) dst[m][k] = *(const LAS bf16x8*)(lds + PG8_SA(b, h) + aoff + m * 2048 + k * 1024); } while (0)
#define PG8_LDB(dst, b, h) do { _Pragma("unroll") for (int n = 0; n < 2; ++n) _Pragma("unroll") for (int k = 0; k < 2; ++k) dst[n][k] = *(const LAS bf16x8*)(lds + PG8_SB(b, h) + boff + n * 2048 + k * 1024); } while (0)
#define PG8_MMA(ai, bj, At, Bt) do { __builtin_amdgcn_s_setprio(1); _Pragma("unroll") for (int m = 0; m < 4; ++m) _Pragma("unroll") for (int n = 0; n < 2; ++n) _Pragma("unroll") for (int k = 0; k < 2; ++k) \
        acc[ai][bj][m][n] = __builtin_amdgcn_mfma_f32_16x16x32_bf16(Bt[n][k], At[m][k], acc[ai][bj][m][n], 0, 0, 0); __builtin_amdgcn_s_setprio(0); } while (0)
#define PG8_WAIT_V(n) asm volatile("s_waitcnt vmcnt(" #n ")" ::: "memory")
#define PG8_WAIT_L(n) asm volatile("s_waitcnt lgkmcnt(" #n ")" ::: "memory")
#define PG8_BAR __builtin_amdgcn_s_barrier()
#define PG8_SCHED __builtin_amdgcn_sched_barrier(0)
    Unit cur, nxt; int ui = 0;
    if (!S.next(0, cur)) return;
    f32x4 acc[2][2][4][2];
#pragma unroll
    for (int a = 0; a < 2; ++a)
#pragma unroll
        for (int b = 0; b < 2; ++b)
#pragma unroll
            for (int m = 0; m < 4; ++m)
#pragma unroll
                for (int n = 0; n < 2; ++n) acc[a][b][m][n] = (f32x4){0.f, 0.f, 0.f, 0.f};
    bf16x8 At[4][2], B0[2][2], B1[2][2];
    const char* cA = (const char*)g.A + (size_t)cur.pm * tstep; const char* cB = (const char*)g.Bt + (size_t)cur.pn * tstep;
    PG8_STAGE(PG8_SB(0, 0), cB, voffB); PG8_STAGE(PG8_SA(0, 0), cA, voffA); PG8_STAGE(PG8_SB(0, 1), cB + hstep, voffB); PG8_STAGE(PG8_SA(0, 1), cA + hstep, voffA);
    if (wr == 1) PG8_BAR;
    PG8_WAIT_V(4); PG8_BAR;
    PG8_STAGE(PG8_SB(1, 0), cB + kstep, voffB); PG8_STAGE(PG8_SA(1, 0), cA + kstep, voffA); PG8_STAGE(PG8_SB(1, 1), cB + hstep + kstep, voffB);
    PG8_WAIT_V(6); PG8_BAR;
    for (;;) {
        const bool has_next = S.next(ui + 1, nxt);
        const char* nA = has_next ? (const char*)g.A + (size_t)nxt.pm * tstep : cA; const char* nB = has_next ? (const char*)g.Bt + (size_t)nxt.pn * tstep : cB;
        for (int t = 0; t < nt; t += 2) {
            const bool last = (t == nt - 2);
            const char* a1 = cA + (size_t)(t + 1) * kstep;
            const char* a2 = last ? nA : cA + (size_t)(t + 2) * kstep; const char* b2 = last ? nB : cB + (size_t)(t + 2) * kstep;
            const char* a3 = a2 + kstep; const char* b3 = b2 + kstep;
            PG8_LDB(B0, 0, 0); PG8_SCHED; PG8_LDA(At, 0, 0); PG8_STAGE(PG8_SA(1, 1), a1 + hstep, voffA);
            PG8_WAIT_L(8); PG8_BAR; PG8_WAIT_L(0); PG8_MMA(0, 0, At, B0); PG8_BAR; PG8_SCHED;
            PG8_LDB(B1, 0, 1); PG8_STAGE(PG8_SB(0, 0), b2, voffB);
            PG8_BAR; PG8_WAIT_L(0); PG8_MMA(0, 1, At, B1); PG8_BAR;
            PG8_LDA(At, 0, 1); PG8_STAGE(PG8_SA(0, 0), a2, voffA);
            PG8_BAR; PG8_WAIT_L(0); PG8_MMA(1, 0, At, B0); PG8_BAR; PG8_SCHED;
            PG8_STAGE(PG8_SB(0, 1), b2 + hstep, voffB);
            PG8_WAIT_V(6); PG8_BAR; PG8_MMA(1, 1, At, B1); PG8_BAR;
            PG8_LDB(B0, 1, 0); PG8_SCHED; PG8_LDA(At, 1, 0); PG8_STAGE(PG8_SA(0, 1), a2 + hstep, voffA);
            PG8_WAIT_L(8); PG8_BAR; PG8_WAIT_L(0); PG8_MMA(0, 0, At, B0); PG8_BAR; PG8_SCHED;
            PG8_LDB(B1, 1, 1); PG8_STAGE(PG8_SB(1, 0), b3, voffB);
            PG8_BAR; PG8_WAIT_L(0); PG8_MMA(0, 1, At, B1); PG8_BAR;
            PG8_LDA(At, 1, 1); PG8_STAGE(PG8_SA(1, 0), a3, voffA);
            PG8_BAR; PG8_WAIT_L(0); PG8_MMA(1, 0, At, B0); PG8_BAR; PG8_SCHED;
            PG8_STAGE(PG8_SB(1, 1), b3 + hstep, voffB);
            PG8_WAIT_V(6); PG8_BAR; PG8_MMA(1, 1, At, B1); PG8_BAR;
        }
        E(acc, cur, wr, wc, fr, fq);
        if (!has_next) break;
#pragma unroll
        for (int a = 0; a < 2; ++a)
#pragma unroll
            for (int b = 0; b < 2; ++b)
#pragma unroll
                for (int m = 0; m < 4; ++m)
#pragma unroll
                    for (int n = 0; n < 2; ++n) acc[a][b][m][n] = (f32x4){0.f, 0.f, 0.f, 0.f};
        cur = nxt; cA = nA; cB = nB; ++ui;
    }
    PG8_WAIT_V(0);
    if (wr == 0) PG8_BAR;
    PG8_BAR;
#undef PG8_SA
#undef PG8_SB
#undef PG8_STAGE
#undef PG8_LDA
#undef PG8_LDB
#undef PG8_MMA
#undef PG8_WAIT_V
#undef PG8_WAIT_L
#undef PG8_BAR
#undef PG8_SCHED
}
}

struct Params {
    const float *x, *c, *w_ada, *b_ada, *g_pre_mix, *g_post_mix, *g_pre_ffn, *g_post_ffn, *w_in, *b_fgate, *swa_sinks, *w_out, *w_query, *sub_keys, *w_u, *w_v;
    float* out; unsigned char* ws;
};

__device__ __forceinline__ void phase0(const Params& p, LAS unsigned char* lds) {
    const int tid = fresh_tid();
    float* mod = (float*)(p.ws + WS_MOD);
    if (blockIdx.x < NMOD / 32) {
        LAS float* sc = (LAS float*)lds;
        LAS float* red = (LAS float*)(lds + 16384);
        for (int i = tid; i < BATCH * DM; i += NTHREADS) { const float cv = p.c[i]; sc[i] = cv / (1.f + __expf(-cv)); }
        __syncthreads();
        const int cl = tid & 31, ks = tid >> 5, col = blockIdx.x * 32 + cl;
        float a0 = 0.f, a1 = 0.f, a2 = 0.f, a3 = 0.f;
#pragma unroll 32
        for (int k = ks * 64; k < ks * 64 + 64; ++k) { const float w = p.w_ada[(size_t)k * NMOD + col]; a0 += sc[k] * w; a1 += sc[DM + k] * w; a2 += sc[2 * DM + k] * w; a3 += sc[3 * DM + k] * w; }
        red[(ks * 4 + 0) * 32 + cl] = a0; red[(ks * 4 + 1) * 32 + cl] = a1; red[(ks * 4 + 2) * 32 + cl] = a2; red[(ks * 4 + 3) * 32 + cl] = a3;
        __syncthreads();
        if (tid < 128) { const int b = tid >> 5, c2 = tid & 31; float s = 0.f;
#pragma unroll
            for (int k = 0; k < 16; ++k) s += red[(k * 4 + b) * 32 + c2];
            mod[b * NMOD + blockIdx.x * 32 + c2] = s + p.b_ada[blockIdx.x * 32 + c2]; }
        __syncthreads();
    }
    const size_t gt = (size_t)blockIdx.x * NTHREADS + tid, ng = (size_t)gridDim.x * NTHREADS;
    {
        const int lane = tid & 63, gw = blockIdx.x * NWAVES + (tid >> 6), ngw = gridDim.x * NWAVES;
        unsigned char* U6 = p.ws + WS_U8; unsigned char* V8 = p.ws + WS_V8; float* SU = (float*)(p.ws + WS_SU); float* SV = (float*)(p.ws + WS_SV);
        for (int r = gw; r < 8192 + 8192; r += ngw) {
            const bool isv = r < 8192;
            const int e = 2 * (isv ? r : r - 8192) + (lane >> 5), l32 = lane & 31;
            const float* src = (isv ? p.w_v : p.w_u) + (size_t)e * DM + 32 * l32;
            f32x4 q[8]; float mx = 0.f;
#pragma unroll
            for (int k = 0; k < 8; ++k) { q[k] = *(const f32x4*)(src + 4 * k);
#pragma unroll
                for (int i = 0; i < 4; ++i) mx = fmaxf(mx, fabsf(q[k][i])); }
#pragma unroll
            for (int o = 1; o < 32; o <<= 1) mx = fmaxf(mx, __shfl_xor(mx, o));
            const float sc = mx > 0.f ? 6.f / mx : 1.f, isc = mx > 0.f ? mx * (1.f / 6.f) : 1.f;
            u32x4 w;
#pragma unroll
            for (int d = 0; d < 4; ++d) { unsigned t_ = 0u;
                t_ = __builtin_amdgcn_cvt_scalef32_pk_fp4_f32(t_, q[2 * d][0] * sc, q[2 * d][1] * sc, 1.0f, 0);
                t_ = __builtin_amdgcn_cvt_scalef32_pk_fp4_f32(t_, q[2 * d][2] * sc, q[2 * d][3] * sc, 1.0f, 1);
                t_ = __builtin_amdgcn_cvt_scalef32_pk_fp4_f32(t_, q[2 * d + 1][0] * sc, q[2 * d + 1][1] * sc, 1.0f, 2);
                t_ = __builtin_amdgcn_cvt_scalef32_pk_fp4_f32(t_, q[2 * d + 1][2] * sc, q[2 * d + 1][3] * sc, 1.0f, 3);
                w[d] = t_; }
            *(u32x4*)((isv ? V8 : U6) + (size_t)e * 512 + 16 * l32) = w;
            if (l32 == 0) (isv ? SV : SU)[e] = isc;
        }
    }
    {
        bf16_t* SK = (bf16_t*)(p.ws + WS_SK); const size_t n8 = 16 * 128 * 128 / 8;
        for (size_t i = gt; i < n8; i += ng) { const float* src = p.sub_keys + i * 8; const f32x4 a = *(const f32x4*)src, b = *(const f32x4*)(src + 4);
            u32x4 w; w.x = cvtpk(a[0], a[1]); w.y = cvtpk(a[2], a[3]); w.z = cvtpk(b[0], b[1]); w.w = cvtpk(b[2], b[3]); *(u32x4*)(SK + i * 8) = w; }
    }
    {
        bf16_t* WTI = (bf16_t*)(p.ws + WS_WTIN); bf16_t* WTO = (bf16_t*)(p.ws + WS_WTOUT); bf16_t* WTQ = (bf16_t*)(p.ws + WS_WTQ);
        const size_t nI = (size_t)NPROJ * 128, nO = (size_t)1024 * 128, nQ = (size_t)2048 * 128;
        for (size_t i0_ = gt; i0_ < nI + nO + nQ; i0_ += 3 * ng) {
            float v[3][8]; bf16_t* dst[3];
#pragma unroll
            for (int q = 0; q < 3; ++q) {
                const size_t i = i0_ + (size_t)q * ng; const bool ok = i < nI + nO + nQ; const size_t ii = ok ? i : gt;
                const float* W; bf16_t* WT; int N, pitch, n, kc, sc_;
                if (ii < nI) { N = NPROJ; pitch = INW; W = p.w_in; WT = WTI; n = (int)(ii % N); kc = (int)(ii / N); sc_ = n < 1536 ? n : n + 8; }
                else if (ii < nI + nO) { const size_t j = ii - nI; N = 1024; pitch = 1024; W = p.w_out; WT = WTO; n = (int)(j % N); kc = (int)(j / N); sc_ = n; }
                else { const size_t j = ii - nI - nO; N = 2048; pitch = 2048; W = p.w_query; WT = WTQ; n = (int)(j % N); kc = (int)(j / N); sc_ = n; }
#pragma unroll
                for (int j = 0; j < 8; ++j) v[q][j] = W[(size_t)(kc * 8 + j) * pitch + sc_];
                dst[q] = ok ? WT + (size_t)n * 1024 + kc * 8 : nullptr;
            }
#pragma unroll
            for (int q = 0; q < 3; ++q) if (dst[q]) { u32x4 w; w.x = cvtpk(v[q][0], v[q][1]); w.y = cvtpk(v[q][2], v[q][3]); w.z = cvtpk(v[q][4], v[q][5]); w.w = cvtpk(v[q][6], v[q][7]); *(u32x4*)dst[q] = w; }
        }
    }
    {
        float* WF = (float*)(p.ws + WS_WF);
        for (size_t i = gt; i < 8 * 1024; i += ng) { const int hd = (int)(i & 7), k = (int)(i >> 3); WF[hd * 1024 + k] = p.w_in[(size_t)k * INW + 1536 + hd]; }
    }
}

__device__ __forceinline__ void ld16(const float* rowp, int lane, float (&v)[16]) {
    const f32x4 a = *(const f32x4*)(rowp + 8 * lane), b = *(const f32x4*)(rowp + 8 * lane + 4), c = *(const f32x4*)(rowp + 512 + 8 * lane), d = *(const f32x4*)(rowp + 512 + 8 * lane + 4);
#pragma unroll
    for (int i = 0; i < 4; ++i) { v[i] = a[i]; v[4 + i] = b[i]; v[8 + i] = c[i]; v[12 + i] = d[i]; }
}
__device__ __forceinline__ void st16_bf16(bf16_t* rowp, int lane, const float (&v)[16]) {
    u32x4 w0, w1; w0.x = cvtpk(v[0], v[1]); w0.y = cvtpk(v[2], v[3]); w0.z = cvtpk(v[4], v[5]); w0.w = cvtpk(v[6], v[7]);
    w1.x = cvtpk(v[8], v[9]); w1.y = cvtpk(v[10], v[11]); w1.z = cvtpk(v[12], v[13]); w1.w = cvtpk(v[14], v[15]);
    *(u32x4*)(rowp + 8 * lane) = w0; *(u32x4*)(rowp + 512 + 8 * lane) = w1;
}
__device__ __forceinline__ void ld16_bf16(const bf16_t* rowp, int lane, float (&v)[16]) {
    const u32x4 w0 = *(const u32x4*)(rowp + 8 * lane), w1 = *(const u32x4*)(rowp + 512 + 8 * lane);
    v[0] = bflo(w0.x); v[1] = bfhi(w0.x); v[2] = bflo(w0.y); v[3] = bfhi(w0.y); v[4] = bflo(w0.z); v[5] = bfhi(w0.z); v[6] = bflo(w0.w); v[7] = bfhi(w0.w);
    v[8] = bflo(w1.x); v[9] = bfhi(w1.x); v[10] = bflo(w1.y); v[11] = bfhi(w1.y); v[12] = bflo(w1.z); v[13] = bfhi(w1.z); v[14] = bflo(w1.w); v[15] = bfhi(w1.w);
}
__device__ __forceinline__ void st16(float* rowp, int lane, const float (&v)[16]) {
    *(f32x4*)(rowp + 8 * lane) = (f32x4){v[0], v[1], v[2], v[3]}; *(f32x4*)(rowp + 8 * lane + 4) = (f32x4){v[4], v[5], v[6], v[7]};
    *(f32x4*)(rowp + 512 + 8 * lane) = (f32x4){v[8], v[9], v[10], v[11]}; *(f32x4*)(rowp + 512 + 8 * lane + 4) = (f32x4){v[12], v[13], v[14], v[15]};
}

#define DPP_ADDF(v, ctrl) v += __uint_as_float((unsigned)__builtin_amdgcn_update_dpp(0, (int)__float_as_uint(v), ctrl, 0xf, 0xf, true))
__device__ __forceinline__ float wave_sum_dpp(float v) {
    DPP_ADDF(v, 0xB1); DPP_ADDF(v, 0x4E); DPP_ADDF(v, 0x141); DPP_ADDF(v, 0x140);
    const float a = __uint_as_float((unsigned)__builtin_amdgcn_readlane((int)__float_as_uint(v), 0)), b = __uint_as_float((unsigned)__builtin_amdgcn_readlane((int)__float_as_uint(v), 16));
    const float c = __uint_as_float((unsigned)__builtin_amdgcn_readlane((int)__float_as_uint(v), 32)), d = __uint_as_float((unsigned)__builtin_amdgcn_readlane((int)__float_as_uint(v), 48));
    return (a + b) + (c + d);
}
__device__ __forceinline__ void phase1(const Params& p, LAS unsigned char* lds) {
    const int tid_ = fresh_tid(); const int lane = tid_ & 63, wid = tid_ >> 6;
    const int gw = blockIdx.x * NWAVES + wid, ngw = gridDim.x * NWAVES;
    const float* mod = (const float*)(p.ws + WS_MOD); const float* WF = (const float*)(p.ws + WS_WF);
    bf16_t* H = (bf16_t*)(p.ws + WS_H); float* LS = (float*)(p.ws + WS_LS);
    LAS float* wfl = (LAS float*)lds;
    for (int i = tid_; i < 8 * DM / 4; i += NTHREADS) *(LAS f32x4*)(wfl + 4 * i) = *(const f32x4*)(WF + 4 * i);
    __syncthreads();
    float g[16]; ld16(p.g_pre_mix, lane, g);
    const float bfg = (lane & 7) == 0 ? p.b_fgate[lane >> 3] : 0.f;
    for (int t0 = gw * 16; t0 < T; t0 += ngw * 16) {
        const int b = t0 / SEQ;
        float A[16], sh[16];
        { float sc[16]; ld16(mod + b * NMOD, lane, sh); ld16(mod + b * NMOD + DM, lane, sc);
#pragma unroll
          for (int i = 0; i < 16; ++i) A[i] = g[i] * (1.f + sc[i]); }
        float xn[16]; ld16(p.x + (size_t)t0 * DM, lane, xn);
#pragma unroll 1
        for (int r = 0; r < 16; ++r) {
            const int t = t0 + r;
            float xv[16];
#pragma unroll
            for (int i = 0; i < 16; ++i) xv[i] = xn[i];
            if (r + 1 < 16) ld16(p.x + (size_t)(t + 1) * DM, lane, xn);
            float ss = 0.f;
#pragma unroll
            for (int i = 0; i < 16; ++i) ss += xv[i] * xv[i];
            const float rstd = rsqrtf(wave_sum_dpp(ss) * (1.f / DM) + RMS_EPS);
            float h[16];
#pragma unroll
            for (int i = 0; i < 16; ++i) h[i] = xv[i] * rstd * A[i] + sh[i];
            st16_bf16(H + (size_t)t * DM, lane, h);
            float s[8];
#pragma unroll
            for (int hd = 0; hd < 8; ++hd) {
                const LAS float* wr = wfl + hd * DM;
                const f32x4 w0 = *(const LAS f32x4*)(wr + 8 * lane), w1 = *(const LAS f32x4*)(wr + 8 * lane + 4), w2 = *(const LAS f32x4*)(wr + 512 + 8 * lane), w3 = *(const LAS f32x4*)(wr + 512 + 8 * lane + 4);
                float a = 0.f;
#pragma unroll
                for (int i = 0; i < 4; ++i) a += h[i] * w0[i] + h[4 + i] * w1[i] + h[8 + i] * w2[i] + h[12 + i] * w3[i];
                s[hd] = a;
            }
            const bool b32 = (lane & 32) != 0, b16 = (lane & 16) != 0, b8 = (lane & 8) != 0;
            float r4[4], r2[2], v;
#pragma unroll
            for (int k = 0; k < 4; ++k) { const float mine = b32 ? s[k + 4] : s[k], send = b32 ? s[k] : s[k + 4]; r4[k] = mine + __shfl_xor(send, 32); }
#pragma unroll
            for (int k = 0; k < 2; ++k) { const float mine = b16 ? r4[k + 2] : r4[k], send = b16 ? r4[k] : r4[k + 2]; r2[k] = mine + __shfl_xor(send, 16); }
            { const float mine = b8 ? r2[1] : r2[0], send = b8 ? r2[0] : r2[1]; v = mine + __shfl_xor(send, 8); }
            v += __shfl_xor(v, 4); v += __shfl_xor(v, 2); v += __shfl_xor(v, 1);
            if ((lane & 7) == 0) { const float z = v + bfg;
                const float lsg = z >= 0.f ? -log1pf(__expf(-z)) : z - log1pf(__expf(z));
                LS[(size_t)t * 8 + (lane >> 3)] = lsg; }
        }
    }
    __syncthreads();
}

__device__ __forceinline__ void scan_kb(const Params& p, LAS unsigned char* lds) {
    const int first = (int)gridDim.x >= BATCH * 8 ? (int)gridDim.x - BATCH * 8 : 0;
    for (int sb = (int)blockIdx.x - first; sb >= 0 && sb < BATCH * 8; sb += (int)gridDim.x) {
        const int tid = fresh_tid(), lane = tid & 63, wid = tid >> 6, b = sb >> 3, hd = sb & 7;
        const float* LS = (const float*)(p.ws + WS_LS) + (size_t)b * SEQ * 8 + hd; float* KB = (float*)(p.ws + WS_KB) + (size_t)sb * SEQ;
        LAS double* wtot = (LAS double*)lds;
        double loc[16]; double s = 0.0;
#pragma unroll
        for (int i = 0; i < 16; ++i) { s += (double)LS[(size_t)(tid * 16 + i) * 8]; loc[i] = s; }
        double v = s;
#pragma unroll
        for (int o = 1; o < 64; o <<= 1) { const double u = __shfl_up(v, o); if (lane >= o) v += u; }
        __syncthreads();
        if (lane == 63) wtot[wid] = v;
        __syncthreads();
        double base = v - s;
        for (int w = 0; w < wid; ++w) base += wtot[w];
#pragma unroll
        for (int i = 0; i < 16; ++i) KB[tid * 16 + i] = (float)(-(base + loc[i]) * (double)LOG2E);
        __syncthreads();
    }
}

__device__ __forceinline__ void stage_kv_tile(LAS unsigned char* kimg, LAS unsigned char* vimg, const bf16_t* Kg, const bf16_t* Vg, long row0, long rowmin, int pitch, int wid, int lane) {
    long rk = row0 + lane; if (rk < rowmin) rk = rowmin;
    const bf16_t* ks = Kg + rk * pitch + wid * 8;
    __builtin_amdgcn_global_load_lds((const unsigned*)ks, (LAS unsigned*)(kimg + wid * 1024), 16, 0, 0);
    long rv = row0 + 16 * (wid & 3) + (lane >> 2); if (rv < rowmin) rv = rowmin;
    const bf16_t* vs = Vg + rv * pitch + (wid >> 2) * 32 + (lane & 3) * 8;
    __builtin_amdgcn_global_load_lds((const unsigned*)vs, (LAS unsigned*)(vimg + wid * 1024), 16, 0, 0);
}
__device__ __forceinline__ s16x4 vtr(const LAS unsigned char* ptr) {
    typedef short v4i16_t __attribute__((ext_vector_type(4)));
    return __builtin_bit_cast(s16x4, __builtin_amdgcn_ds_read_tr16_b64_v4i16((LAS v4i16_t*)ptr));
}
__device__ __forceinline__ void qk_tile(f32x16& p0, f32x16& p1, const LAS unsigned char* kimg, const bf16x8 (&qr)[4], int r32, int hi) {
    const LAS unsigned char* kb = kimg + hi * 1024 + r32 * 16;
    p0 = (f32x16){}; p1 = (f32x16){};
#pragma unroll
    for (int d0 = 0; d0 < 4; ++d0) {
        const bf16x8 b0 = *(const LAS bf16x8*)(kb + d0 * 2048), b1 = *(const LAS bf16x8*)(kb + d0 * 2048 + 512);
        p0 = __builtin_amdgcn_mfma_f32_32x32x16_bf16(b0, qr[d0], p0, 0, 0, 0);
        p1 = __builtin_amdgcn_mfma_f32_32x32x16_bf16(b1, qr[d0], p1, 0, 0, 0);
    }
}
__device__ __forceinline__ void softmax_pv(f32x16& p0, f32x16& p1, const LAS unsigned char* vimg, f32x16& o0, f32x16& o1, float& m, float& l, int lane, int hi) {
    float rm = p0[0];
#pragma unroll
    for (int r = 1; r < 16; ++r) rm = fmaxf(rm, p0[r]);
#pragma unroll
    for (int r = 0; r < 16; ++r) rm = fmaxf(rm, p1[r]);
    rm = fmaxf(rm, __shfl_xor(rm, 32));
    const float mn = fmaxf(m, rm);
    const float alpha = __builtin_amdgcn_exp2f(m - mn);
    m = mn;
    float ps = 0.f;
#pragma unroll
    for (int r = 0; r < 16; ++r) { p0[r] = __builtin_amdgcn_exp2f(p0[r] - mn); ps += p0[r]; }
#pragma unroll
    for (int r = 0; r < 16; ++r) { p1[r] = __builtin_amdgcn_exp2f(p1[r] - mn); ps += p1[r]; }
    l = l * alpha + ps;
    if (!__all(alpha == 1.0f)) {
#pragma unroll
        for (int r = 0; r < 16; ++r) { const float a = __shfl(alpha, crow(r, hi)); o0[r] *= a; o1[r] *= a; }
    }
    u32x4 pw[4];
    pw[0] = (u32x4){cvtpk(p0[0], p0[1]), cvtpk(p0[2], p0[3]), cvtpk(p0[4], p0[5]), cvtpk(p0[6], p0[7])};
    pw[1] = (u32x4){cvtpk(p0[8], p0[9]), cvtpk(p0[10], p0[11]), cvtpk(p0[12], p0[13]), cvtpk(p0[14], p0[15])};
    pw[2] = (u32x4){cvtpk(p1[0], p1[1]), cvtpk(p1[2], p1[3]), cvtpk(p1[4], p1[5]), cvtpk(p1[6], p1[7])};
    pw[3] = (u32x4){cvtpk(p1[8], p1[9]), cvtpk(p1[10], p1[11]), cvtpk(p1[12], p1[13]), cvtpk(p1[14], p1[15])};
    const LAS unsigned char* vb = vimg + ((lane >> 4) & 1) * 32 + (lane & 3) * 8 + (4 * hi + ((lane & 15) >> 2)) * 64;
#pragma unroll
    for (int ks = 0; ks < 4; ++ks) {
        const bf16x8 pa = __builtin_bit_cast(bf16x8, pw[ks]);
        { const s16x4 lo = vtr(vb + ks * 1024), hh = vtr(vb + ks * 1024 + 512);
          const bf16x8 vf = (bf16x8){lo[0], lo[1], lo[2], lo[3], hh[0], hh[1], hh[2], hh[3]};
          o0 = __builtin_amdgcn_mfma_f32_32x32x16_bf16(pa, vf, o0, 0, 0, 0); }
        { const s16x4 lo = vtr(vb + 4096 + ks * 1024), hh = vtr(vb + 4096 + ks * 1024 + 512);
          const bf16x8 vf = (bf16x8){lo[0], lo[1], lo[2], lo[3], hh[0], hh[1], hh[2], hh[3]};
          o1 = __builtin_amdgcn_mfma_f32_32x32x16_bf16(pa, vf, o1, 0, 0, 0); }
    }
}
__device__ __forceinline__ void store_o(bf16_t* Obase  , int pitch, const f32x16& o0, const f32x16& o1, float linv, int r32, int hi) {
#pragma unroll
    for (int r = 0; r < 16; ++r) { const int q = crow(r, hi); const float li = __shfl(linv, q);
        bf16_t* rp = Obase + (size_t)q * pitch;
        rp[r32] = (bf16_t)(cvtpk(o0[r] * li, 0.f) & 0xffffu); rp[32 + r32] = (bf16_t)(cvtpk(o1[r] * li, 0.f) & 0xffffu); }
}

constexpr float FOX_THR = 30.f;
__device__ __forceinline__ void glds16(const void* gsrc, unsigned lds_dst) {
    unsigned keep;
    asm volatile("s_mov_b32 %0, m0\n\ts_mov_b32 m0, %2\n\ts_nop 0\n\tglobal_load_lds_dwordx4 %1, off\n\ts_mov_b32 m0, %0" : "=&s"(keep) : "v"(gsrc), "s"(lds_dst) : "memory");
}
__device__ __forceinline__ unsigned f2ord(float f) { const unsigned b = __float_as_uint(f); return (b & 0x80000000u) ? ~b : (b | 0x80000000u); }
__device__ __forceinline__ float ord2f(unsigned u) { return __uint_as_float((u & 0x80000000u) ? (u & 0x7fffffffu) : ~u); }
__device__ __forceinline__ void fox_prepass(const Params& p) {
    const int tid = fresh_tid(), lane = tid & 63, gw = blockIdx.x * NWAVES + (tid >> 6), ngw = gridDim.x * NWAVES;
    const bf16_t* PROJ = (const bf16_t*)(p.ws + WS_PROJ); float* KT = (float*)(p.ws + WS_KT);
    for (int it = gw; it < 32 * 128; it += ngw) {
        const int bh = it >> 7, j = it & 127, b = bh >> 3, h = bh & 7;
        const bf16_t* kr = PROJ + (size_t)((long)b * SEQ + 64 * j + lane) * NPROJ + 512 + h * 64;
        float ss = 0.f;
#pragma unroll
        for (int c = 0; c < 8; ++c) { const u32x4 w = *(const u32x4*)(kr + 8 * c);
            ss += bflo(w.x) * bflo(w.x) + bfhi(w.x) * bfhi(w.x) + bflo(w.y) * bflo(w.y) + bfhi(w.y) * bfhi(w.y) + bflo(w.z) * bflo(w.z) + bfhi(w.z) * bfhi(w.z) + bflo(w.w) * bflo(w.w) + bfhi(w.w) * bfhi(w.w); }
#pragma unroll
        for (int o = 1; o < 64; o <<= 1) ss = fmaxf(ss, __shfl_xor(ss, o));
        if (lane == 0) KT[it] = ss;
    }
}
constexpr int FOX_BUF = 16384, FOX_NBUF = 4, FOX_KB_OFF = FOX_NBUF * FOX_BUF, FOX_CTL_OFF = FOX_KB_OFF + 32768;
#define FOX_WAIT_BAR(N) asm volatile("s_waitcnt vmcnt(" #N ")\n\ts_barrier" ::: "memory")
__device__ __forceinline__ void fox_stage(unsigned ldsbase, int slot, const bf16_t* Kg, const bf16_t* Vg, long row0, int wid, int lane) {
    const bf16_t* ks = Kg + (row0 + lane) * NPROJ + wid * 8;
    const bf16_t* vs = Vg + (row0 + 16 * (wid & 3) + (lane >> 2)) * NPROJ + (wid >> 2) * 32 + (lane & 3) * 8;
    const unsigned dst = (unsigned)__builtin_amdgcn_readfirstlane((int)(ldsbase + (unsigned)slot * FOX_BUF + (unsigned)wid * 1024u));
    glds16(ks, dst); glds16(vs, dst + 8192u);
}
__device__ __forceinline__ void fox_unit(const Params& p, LAS unsigned char* lds, int b, int h, int qb) {
    const int tid = fresh_tid(), lane = tid & 63, wid = __builtin_amdgcn_readfirstlane(tid >> 6), r32 = lane & 31, hi = lane >> 5;
    const bf16_t* PROJ = (const bf16_t*)(p.ws + WS_PROJ);
    bf16_t* ATT = (bf16_t*)(p.ws + WS_ATT);
    const float* KB = (const float*)(p.ws + WS_KB) + (size_t)(b * 8 + h) * SEQ;
    const float* KT = (const float*)(p.ws + WS_KT) + (b * 8 + h) * 128;
    const long rowb = (long)b * SEQ; const int q0 = qb * 256;
    const bf16_t* Kg = PROJ + 512 + h * 64; const bf16_t* Vg = PROJ + 1024 + h * 64;
    LAS float* kbl = (LAS float*)(lds + FOX_KB_OFF); LAS unsigned* ctl = (LAS unsigned*)(lds + FOX_CTL_OFF);
    const unsigned ldsbase = (unsigned)(uintptr_t)lds;
    const int qw = q0 + 32 * wid;
    const int NT = (q0 + 256) / 64;
    bf16x8 qr[4]; float qn2 = 0.f, xs = 0.f;
#pragma unroll
    for (int d0 = 0; d0 < 4; ++d0) {
        qr[d0] = *(const bf16x8*)(PROJ + (size_t)(rowb + qw + r32) * NPROJ + h * 64 + d0 * 16 + hi * 8);
        const bf16x8 kk = *(const bf16x8*)(PROJ + (size_t)(rowb + qw + r32) * NPROJ + 512 + h * 64 + d0 * 16 + hi * 8);
#pragma unroll
        for (int j = 0; j < 8; ++j) { const float v = __uint_as_float(((unsigned)(unsigned short)qr[d0][j]) << 16), kv = __uint_as_float(((unsigned)(unsigned short)kk[j]) << 16); qn2 += v * v; xs += v * kv; }
    }
    qn2 += __shfl_xor(qn2, 32); xs += __shfl_xor(xs, 32);
    const float kbq = KB[qw + r32];
    float kt_ = 0.f, kbe_ = 0.f;
    if (tid < NT) { kt_ = KT[tid]; kbe_ = KB[64 * tid + 63]; }
    __syncthreads();
    if (tid == 0) { ctl[0] = 0u; ctl[1] = (unsigned)(NT - 4); ctl[2] = 0u; ctl[3] = 0xffffffffu; }
    __syncthreads();
    { float qm = qn2, sm = xs + kbq;
#pragma unroll
      for (int o = 1; o < 32; o <<= 1) { qm = fmaxf(qm, __shfl_xor(qm, o)); sm = fminf(sm, __shfl_xor(sm, o)); }
      if (lane == 0) { atomicMax((unsigned*)&ctl[0], __float_as_uint(qm)); atomicMin((unsigned*)&ctl[3], f2ord(sm)); } }
    __syncthreads();
    const float qmax2 = __uint_as_float(ctl[0]);
    if (tid < NT - 4) {
        const float smin = ord2f(ctl[3]);
        const float ub = sqrtf(qmax2 * kt_) * 1.0001f + kbe_;
        if (!(ub + FOX_THR <= smin - 1e-3f * fabsf(smin))) atomicMin((unsigned*)&ctl[1], (unsigned)tid);
    }
    __syncthreads();
    const int jstart = (int)ctl[1];
    __builtin_amdgcn_s_waitcnt(0);
    fox_stage(ldsbase, 0, Kg, Vg, rowb + 64 * jstart, wid, lane);
    if (jstart + 1 < NT) fox_stage(ldsbase, 1, Kg, Vg, rowb + 64 * (jstart + 1), wid, lane);
    if (jstart + 2 < NT) fox_stage(ldsbase, 2, Kg, Vg, rowb + 64 * (jstart + 2), wid, lane);
    if (tid >= jstart && tid < NT) atomicMax((unsigned*)&ctl[2], __float_as_uint(kt_));
    for (int i = 64 * jstart + tid; i < 64 * NT; i += NTHREADS) kbl[i - 64 * jstart] = KB[i];
    __syncthreads();
    const float kmaxu = sqrtf(__uint_as_float(ctl[2]));
    const float ref = sqrtf(qn2) * kmaxu * 1.0001f + kbq;
    f32x16 o0 = (f32x16){}, o1 = (f32x16){}; float l = 0.f;
    for (int jt = jstart; jt < NT; ++jt) {
        if (jt + 2 < NT) FOX_WAIT_BAR(4); else if (jt + 1 < NT) FOX_WAIT_BAR(2); else FOX_WAIT_BAR(0);
        if (jt + 3 < NT) fox_stage(ldsbase, (jt + 3 - jstart) & 3, Kg, Vg, rowb + 64 * (jt + 3), wid, lane);
        LAS unsigned char* buf = lds + ((jt - jstart) & 3) * FOX_BUF;
        if (64 * jt <= qw + 31) {
            const LAS float* kbt = kbl + 64 * (jt - jstart);
            f32x16 p0, p1;
#pragma unroll
            for (int g = 0; g < 4; ++g) {
                const f32x4 k0 = *(const LAS f32x4*)(kbt + 8 * g + 4 * hi), k1 = *(const LAS f32x4*)(kbt + 32 + 8 * g + 4 * hi);
#pragma unroll
                for (int i = 0; i < 4; ++i) { p0[4 * g + i] = k0[i] - ref; p1[4 * g + i] = k1[i] - ref; }
            }
            { const LAS unsigned char* kb_ = buf + hi * 1024 + r32 * 16;
#pragma unroll
              for (int d0 = 0; d0 < 4; ++d0) {
                  const bf16x8 b0 = *(const LAS bf16x8*)(kb_ + d0 * 2048), b1 = *(const LAS bf16x8*)(kb_ + d0 * 2048 + 512);
                  p0 = __builtin_amdgcn_mfma_f32_32x32x16_bf16(b0, qr[d0], p0, 0, 0, 0);
                  p1 = __builtin_amdgcn_mfma_f32_32x32x16_bf16(b1, qr[d0], p1, 0, 0, 0);
              } }
            float ps = 0.f;
            if (64 * jt + 63 > qw) {
                const int tq = qw + r32;
#pragma unroll
                for (int r = 0; r < 16; ++r) { const int s_ = 64 * jt + crow(r, hi);
                    p0[r] = (s_ > tq) ? 0.f : __builtin_amdgcn_exp2f(p0[r]); p1[r] = (s_ + 32 > tq) ? 0.f : __builtin_amdgcn_exp2f(p1[r]); ps += p0[r] + p1[r]; }
            } else {
#pragma unroll
                for (int r = 0; r < 16; ++r) { p0[r] = __builtin_amdgcn_exp2f(p0[r]); p1[r] = __builtin_amdgcn_exp2f(p1[r]); ps += p0[r] + p1[r]; }
            }
            l += ps;
            u32x4 pw[4];
            pw[0] = (u32x4){cvtpk(p0[0], p0[1]), cvtpk(p0[2], p0[3]), cvtpk(p0[4], p0[5]), cvtpk(p0[6], p0[7])};
            pw[1] = (u32x4){cvtpk(p0[8], p0[9]), cvtpk(p0[10], p0[11]), cvtpk(p0[12], p0[13]), cvtpk(p0[14], p0[15])};
            pw[2] = (u32x4){cvtpk(p1[0], p1[1]), cvtpk(p1[2], p1[3]), cvtpk(p1[4], p1[5]), cvtpk(p1[6], p1[7])};
            pw[3] = (u32x4){cvtpk(p1[8], p1[9]), cvtpk(p1[10], p1[11]), cvtpk(p1[12], p1[13]), cvtpk(p1[14], p1[15])};
            const LAS unsigned char* vb = buf + 8192 + ((lane >> 4) & 1) * 32 + (lane & 3) * 8 + (4 * hi + ((lane & 15) >> 2)) * 64;
#pragma unroll
            for (int ks = 0; ks < 4; ++ks) {
                const bf16x8 pa = __builtin_bit_cast(bf16x8, pw[ks]);
                { const s16x4 lo = vtr(vb + ks * 1024), hh = vtr(vb + ks * 1024 + 512);
                  const bf16x8 vf = (bf16x8){lo[0], lo[1], lo[2], lo[3], hh[0], hh[1], hh[2], hh[3]};
                  o0 = __builtin_amdgcn_mfma_f32_32x32x16_bf16(pa, vf, o0, 0, 0, 0); }
                { const s16x4 lo = vtr(vb + 4096 + ks * 1024), hh = vtr(vb + 4096 + ks * 1024 + 512);
                  const bf16x8 vf = (bf16x8){lo[0], lo[1], lo[2], lo[3], hh[0], hh[1], hh[2], hh[3]};
                  o1 = __builtin_amdgcn_mfma_f32_32x32x16_bf16(pa, vf, o1, 0, 0, 0); }
            }
        }
    }
    const float lt = l + __shfl_xor(l, 32);
    const float linv = 1.f / lt;
    __syncthreads();
    {
        LAS bf16_t* stg = (LAS bf16_t*)(lds + wid * 4096);
#pragma unroll
        for (int r = 0; r < 16; ++r) { const int q = crow(r, hi); const float li = __shfl(linv, q);
            stg[q * 64 + r32] = (bf16_t)(cvtpk(o0[r] * li, 0.f) & 0xffffu); stg[q * 64 + 32 + r32] = (bf16_t)(cvtpk(o1[r] * li, 0.f) & 0xffffu); }
        bf16_t* Ow = ATT + (size_t)(rowb + qw) * DM + h * 64;
#pragma unroll
        for (int i = 0; i < 4; ++i) { const int row = i * 8 + (lane >> 3), ch = lane & 7; const u32x4 v = *(const LAS u32x4*)(stg + row * 64 + ch * 8); *(u32x4*)(Ow + (size_t)row * DM + ch * 8) = v; }
    }
}
__device__ __forceinline__ void phase_fox(const Params& p, LAS unsigned char* lds) {
    if ((gridDim.x & 7) == 0) {
        unsigned* qw_ = (unsigned*)(p.ws + WS_BAR) + 16 * (blockIdx.x & 7);
        LAS int* uq = (LAS int*)(lds + FOX_CTL_OFF + 64);
        const int x = blockIdx.x & 7;
        for (;;) {
            __syncthreads();
            if (threadIdx.x == 0) *uq = (int)atomicAdd(qw_, 1u);
            __syncthreads();
            const int u = *uq;
            if (u >= 128) break;
            const int i = u & 3;
            fox_unit(p, lds, i, (x - i) & 7, 31 - (u >> 2));
        }
    } else {
        for (int u = blockIdx.x; u < 1024; u += gridDim.x) fox_unit(p, lds, (u & 31) >> 3, u & 7, 31 - (u >> 5));
    }
}

__device__ __forceinline__ void swa_unit(const Params& p, LAS unsigned char* lds, int b, int kvh, int qblk) {
    const int tid = fresh_tid(), lane = tid & 63, wid = __builtin_amdgcn_readfirstlane(tid >> 6), r32 = lane & 31, hi = lane >> 5;
    const bf16_t* PROJ = (const bf16_t*)(p.ws + WS_PROJ);
    bf16_t* ATT = (bf16_t*)(p.ws + WS_ATT);
    const long rowb = (long)b * SEQ; const int q0 = qblk * 128;
    const bf16_t* Kg = PROJ + 2048 + kvh * 64; const bf16_t* Vg = PROJ + 2176 + kvh * 64;
    __syncthreads();
#pragma unroll
    for (int j = 0; j < 4; ++j) stage_kv_tile(lds + j * 16384, lds + j * 16384 + 8192, Kg, Vg, rowb + q0 - 128 + 64 * j, rowb, NPROJ, wid, lane);
    __syncthreads();
#pragma unroll 1
    for (int i = 0; i < 2; ++i) {
        const int task = wid * 2 + i, g = task >> 2, sub = task & 3, hq = kvh * 4 + g;
        const int qw = q0 + 32 * sub;
        const float slope = exp2f(-(float)(hq + 1)) * LOG2E;
        bf16x8 qr[4];
#pragma unroll
        for (int d0 = 0; d0 < 4; ++d0) qr[d0] = *(const bf16x8*)(PROJ + (size_t)(rowb + qw + r32) * NPROJ + 1536 + hq * 64 + d0 * 16 + hi * 8);
        f32x16 o0 = (f32x16){}, o1 = (f32x16){}; float m = NEGBIG, l = 0.f;
        const int j0 = (32 * sub + 1) >> 6, j1 = (32 * sub + 159) >> 6;
        for (int j = j0; j <= j1; ++j) {
            f32x16 p0, p1; qk_tile(p0, p1, lds + j * 16384, qr, r32, hi);
            const int tq = 128 + 32 * sub + r32;
#pragma unroll
            for (int r = 0; r < 16; ++r) {
                const int s0 = 64 * j + crow(r, hi), s1 = s0 + 32;
                const int d0 = tq - s0, d1 = tq - s1;
                const bool v0 = (d0 >= 0) && (d0 < 128) && (q0 - 128 + s0 >= 0), v1 = (d1 >= 0) && (d1 < 128) && (q0 - 128 + s1 >= 0);
                p0[r] = v0 ? p0[r] - slope * (float)d0 : NEGBIG; p1[r] = v1 ? p1[r] - slope * (float)d1 : NEGBIG;
            }
            softmax_pv(p0, p1, lds + j * 16384 + 8192, o0, o1, m, l, lane, hi);
        }
        float lt = l + __shfl_xor(l, 32);
        lt += exp2f(p.swa_sinks[hq] * LOG2E - m);
        store_o(ATT + (size_t)(rowb + qw) * DM + 512 + hq * 64, DM, o0, o1, 1.f / lt, r32, hi);
    }
}
__device__ __forceinline__ void phase_swa(const Params& p, LAS unsigned char* lds) {
    for (int u = blockIdx.x; u < BATCH * 2 * 64; u += gridDim.x) { const int bk = u & 7; swa_unit(p, lds, bk >> 1, bk & 1, u >> 3); }
}

__device__ __forceinline__ void phase6(const Params& p) {
    const int tid_ = fresh_tid(); const int lane = tid_ & 63, wid = tid_ >> 6;
    const int gw = blockIdx.x * NWAVES + wid, ngw = gridDim.x * NWAVES;
    const float* mod = (const float*)(p.ws + WS_MOD);
    const bf16_t* Y1 = (const bf16_t*)(p.ws + WS_PROJ); bf16_t* H = (bf16_t*)(p.ws + WS_H);
    float* X1 = (float*)(p.ws + WS_X1); float* HMAX = (float*)(p.ws + WS_HMAX);
    float gpm[16], gpf[16]; ld16(p.g_post_mix, lane, gpm); ld16(p.g_pre_ffn, lane, gpf);
    for (int t0 = gw * 16; t0 < T; t0 += ngw * 16) {
        const int b = t0 / SEQ;
        float G1[16], A2[16], sh[16];
        { float gt[16], sc[16]; ld16(mod + b * NMOD + 2 * DM, lane, gt); ld16(mod + b * NMOD + 3 * DM, lane, sh); ld16(mod + b * NMOD + 4 * DM, lane, sc);
#pragma unroll
          for (int i = 0; i < 16; ++i) { G1[i] = gt[i] * gpm[i]; A2[i] = gpf[i] * (1.f + sc[i]); } }
        float yn[16], xn[16]; ld16_bf16(Y1 + (size_t)t0 * DM, lane, yn); ld16(p.x + (size_t)t0 * DM, lane, xn);
#pragma unroll 1
        for (int r = 0; r < 16; ++r) {
            const int t = t0 + r;
            float y[16], xv[16];
#pragma unroll
            for (int i = 0; i < 16; ++i) { y[i] = yn[i]; xv[i] = xn[i]; }
            if (r + 1 < 16) { ld16_bf16(Y1 + (size_t)(t + 1) * DM, lane, yn); ld16(p.x + (size_t)(t + 1) * DM, lane, xn); }
            float ss = 0.f;
#pragma unroll
            for (int i = 0; i < 16; ++i) ss += y[i] * y[i];
            const float rstd = rsqrtf(wave_sum_dpp(ss) * (1.f / DM) + RMS_EPS);
            float x1[16]; float s2 = 0.f;
#pragma unroll
            for (int i = 0; i < 16; ++i) { x1[i] = xv[i] + G1[i] * (y[i] * rstd); s2 += x1[i] * x1[i]; }
            st16_bf16((bf16_t*)(p.ws + WS_X1) + (size_t)t * DM, lane, x1);
            const float rstd2 = rsqrtf(wave_sum_dpp(s2) * (1.f / DM) + RMS_EPS);
            float h[16]; float hm = 0.f;
#pragma unroll
            for (int i = 0; i < 16; ++i) { h[i] = x1[i] * rstd2 * A2[i] + sh[i]; hm = fmaxf(hm, fabsf(__uint_as_float(cvtpk(h[i], 0.f) << 16))); }
            st16_bf16(H + (size_t)t * DM, lane, h);
#pragma unroll
            for (int o = 1; o < 64; o <<= 1) hm = fmaxf(hm, __shfl_xor(hm, o));
            if (lane == 0) HMAX[t] = hm;
        }
    }
}

template <int N> __device__ __forceinline__ void bitonic_sort_desc(float (&v)[N]) {
#pragma unroll
    for (int k = 2; k <= N; k <<= 1)
#pragma unroll
        for (int j = k >> 1; j > 0; j >>= 1)
#pragma unroll
            for (int i = 0; i < N; ++i) { const int x = i ^ j; if (x > i) { const bool up = ((i & k) == 0); const float a = v[i], b = v[x]; const float mx = vmaxf(a, b), mn = vminf(a, b); v[i] = up ? mx : mn; v[x] = up ? mn : mx; } }
}
__device__ __forceinline__ void bitonic_merge16_desc(float (&v)[16]) {
#pragma unroll
    for (int j = 8; j > 0; j >>= 1)
#pragma unroll
        for (int i = 0; i < 16; ++i) { const int x = i ^ j; if (x > i) { const float a = v[i], b = v[x]; v[i] = vmaxf(a, b); v[x] = vminf(a, b); } }
}
__device__ __forceinline__ void merge_partner(float (&a)[16], int xm) {
    float c[16];
#pragma unroll
    for (int i = 0; i < 16; ++i) c[i] = vmaxf(a[i], __shfl_xor(a[15 - i], xm));
    bitonic_merge16_desc(c);
#pragma unroll
    for (int i = 0; i < 16; ++i) a[i] = c[i];
}
__device__ __forceinline__ unsigned sel4(unsigned w0, unsigned w1, unsigned w2, unsigned w3, unsigned a) {
    const unsigned lo = (a & 4u) ? w1 : w0, hi2 = (a & 4u) ? w3 : w2; const unsigned w = (a & 8u) ? hi2 : lo; return (w >> (8u * (a & 3u))) & 0x7fu;
}
__device__ __forceinline__ void p8_stage(LAS unsigned char* buf, const bf16_t* SK, int g, int wid, int lane) {
#pragma unroll
    for (int j = 0; j < 4; ++j) { const int pc = wid * 4 + j, row = 4 * pc + (lane >> 4), pos = lane & 15;
        const unsigned char* src = (const unsigned char*)SK + (size_t)g * 32768 + row * 256 + ((pos ^ (row & 15)) << 4);
        __builtin_amdgcn_global_load_lds((const unsigned*)src, (LAS unsigned*)(buf + pc * 1024), 16, 0, 0); }
}
__device__ __forceinline__ void phase8_block(const Params& p, LAS unsigned char* lds, int t0, int wid, int lane) {
    const int fr = lane & 15, fq = lane >> 4;
    const bf16_t* Q2 = (const bf16_t*)(p.ws + WS_PROJ); const bf16_t* SK = (const bf16_t*)(p.ws + WS_SK);
    int* EIDX = (int*)(p.ws + WS_EIDX); float* GATE = (float*)(p.ws + WS_GATE);
    float keep[2][2][16];
#pragma unroll
    for (int a_ = 0; a_ < 2; ++a_)
#pragma unroll
        for (int b_ = 0; b_ < 2; ++b_)
#pragma unroll
            for (int i_ = 0; i_ < 16; ++i_) keep[a_][b_][i_] = 0.f;
    const bf16_t* qrow = Q2 + (size_t)(t0 + fr) * 2048 + 8 * fq;
    bf16x8 bqn[4];
#pragma unroll
    for (int s = 0; s < 4; ++s) bqn[s] = *(const bf16x8*)(qrow + 32 * s);
    __syncthreads();
    p8_stage(lds, SK, 0, wid, lane);
#pragma unroll 1
    for (int hp = 0; hp < 4; ++hp) {
#pragma unroll
        for (int hh = 0; hh < 2; ++hh) {
#pragma unroll
            for (int pp = 0; pp < 2; ++pp) {
                const int grp = (2 * hp + hh) * 2 + pp;
                bf16x8 bq[4];
#pragma unroll
                for (int s = 0; s < 4; ++s) bq[s] = bqn[s];
                __syncthreads();
                if (grp + 1 < 16) { p8_stage(lds + ((grp + 1) & 1) * 32768, SK, grp + 1, wid, lane);
#pragma unroll
                    for (int s = 0; s < 4; ++s) bqn[s] = *(const bf16x8*)(qrow + (grp + 1) * 128 + 32 * s); }
                const LAS unsigned char* kb_ = lds + (grp & 1) * 32768 + fr * 256;
                float v[32];
#pragma unroll
                for (int mt = 0; mt < 8; ++mt) {
                    f32x4 acc = (f32x4){0.f, 0.f, 0.f, 0.f};
#pragma unroll
                    for (int s = 0; s < 4; ++s) { const bf16x8 a = *(const LAS bf16x8*)(kb_ + mt * 4096 + (((4 * s + fq) ^ fr) << 4)); acc = __builtin_amdgcn_mfma_f32_16x16x32_bf16(a, bq[s], acc, 0, 0, 0); }
                    unsigned f4 = 4u * (unsigned)fq; asm volatile("" : "+v"(f4));
#pragma unroll
                    for (int i = 0; i < 4; ++i) v[mt * 4 + i] = __uint_as_float(((__float_as_uint(acc[i]) & ~127u) | f4) | (unsigned)(16 * mt + i));
                }
                bitonic_sort_desc<32>(v);
                float a16[16];
#pragma unroll
                for (int i = 0; i < 16; ++i) a16[i] = v[i];
                merge_partner(a16, 16); merge_partner(a16, 32);
                const bool mine = (fq == hp);
#pragma unroll
                for (int i = 0; i < 16; ++i) keep[hh][pp][i] = mine ? a16[i] : keep[hh][pp][i];
            }
        }
    }
#pragma unroll
    for (int hh = 0; hh < 2; ++hh) {
        const float (&L1)[16] = keep[hh][0]; const float (&L2)[16] = keep[hh][1];
#define P8_CAND(a, b) __uint_as_float((__float_as_uint(L1[a] + L2[b]) & ~255u) | (unsigned)((a) * 16 + (b)))
        float R[16], Bl[16], Cl[16];
#pragma unroll
        for (int bb = 0; bb < 16; ++bb) R[bb] = P8_CAND(0, bb);
#pragma unroll
        for (int i = 0; i < 8; ++i) { Bl[i] = P8_CAND(1, i); Bl[8 + i] = P8_CAND(15 - i, 0); }
        bitonic_merge16_desc(Bl);
        Cl[0] = P8_CAND(2, 0); Cl[1] = P8_CAND(2, 1); Cl[2] = P8_CAND(2, 2); Cl[3] = P8_CAND(2, 3); Cl[4] = P8_CAND(2, 4);
        Cl[5] = P8_CAND(3, 0); Cl[6] = P8_CAND(3, 1); Cl[7] = P8_CAND(3, 2); Cl[8] = P8_CAND(3, 3);
        Cl[9] = P8_CAND(4, 0); Cl[10] = P8_CAND(4, 1); Cl[11] = P8_CAND(4, 2);
        Cl[12] = P8_CAND(5, 0); Cl[13] = P8_CAND(5, 1); Cl[14] = P8_CAND(6, 0); Cl[15] = P8_CAND(6, 1);
        bitonic_sort_desc<16>(Cl);
        { float c[16];
#pragma unroll
          for (int i = 0; i < 16; ++i) c[i] = vmaxf(R[i], Bl[15 - i]);
          bitonic_merge16_desc(c);
#pragma unroll
          for (int i = 0; i < 16; ++i) c[i] = vmaxf(c[i], Cl[15 - i]);
          bitonic_merge16_desc(c);
          c[15] = vmaxf(c[15], P8_CAND(7, 0)); c[14] = vmaxf(c[14], P8_CAND(7, 1));
          bitonic_merge16_desc(c);
#pragma unroll
          for (int i = 0; i < 16; ++i) R[i] = c[i]; }
#undef P8_CAND
        unsigned pk1[4], pk2[4];
#pragma unroll
        for (int w = 0; w < 4; ++w) {
            pk1[w] = (__float_as_uint(L1[4 * w]) & 127u) | ((__float_as_uint(L1[4 * w + 1]) & 127u) << 8) | ((__float_as_uint(L1[4 * w + 2]) & 127u) << 16) | ((__float_as_uint(L1[4 * w + 3]) & 127u) << 24);
            pk2[w] = (__float_as_uint(L2[4 * w]) & 127u) | ((__float_as_uint(L2[4 * w + 1]) & 127u) << 8) | ((__float_as_uint(L2[4 * w + 2]) & 127u) << 16) | ((__float_as_uint(L2[4 * w + 3]) & 127u) << 24);
        }
        float mx = R[0];
#pragma unroll
        for (int i = 1; i < 16; ++i) mx = fmaxf(mx, R[i]);
        float e[16]; float se = 0.f;
#pragma unroll
        for (int i = 0; i < 16; ++i) { e[i] = __expf(R[i] - mx); se += e[i]; }
        const float inv = 1.f / se;
        int ex[16];
#pragma unroll
        for (int i = 0; i < 16; ++i) { const unsigned bits = __float_as_uint(R[i]); const unsigned a = (bits >> 4) & 15u, bb = bits & 15u;
            ex[i] = (int)(sel4(pk1[0], pk1[1], pk1[2], pk1[3], a) * 128u + sel4(pk2[0], pk2[1], pk2[2], pk2[3], bb)); e[i] *= inv; }
        const int head = 2 * fq + hh;
        int* ep = EIDX + (size_t)(t0 + fr) * 128 + head * 16; float* gp = GATE + (size_t)(t0 + fr) * 128 + head * 16;
#pragma unroll
        for (int i = 0; i < 16; i += 4) { *(int4*)(ep + i) = make_int4(ex[i], ex[i + 1], ex[i + 2], ex[i + 3]); *(f32x4*)(gp + i) = (f32x4){e[i], e[i + 1], e[i + 2], e[i + 3]}; }
    }
}

__device__ __forceinline__ float gelu_tanh(float x) {
    const float z = 0.7978845608028654f * (x + 0.044715f * x * x * x);
    const float e = __expf(2.f * z); const float th = 1.f - 2.f * __builtin_amdgcn_rcpf(e + 1.f);
    return 0.5f * x * (1.f + th);
}
constexpr int P9_LIST = 0, P9_ACT = 4096, P9_STAGE = 6144, P9_RING = 7168  , P9_VRING = 4096  , P9_WAVE_LDS = 20480, P9_NBATCH = 64, P9_NENT = 1024;
typedef long i64_t;
__device__ __forceinline__ unsigned pk4_fp8(float a, float b, float c, float d) { int t_ = __builtin_amdgcn_cvt_pk_fp8_f32(a, b, 0, false); t_ = __builtin_amdgcn_cvt_pk_fp8_f32(c, d, t_, true); return (unsigned)t_; }

__device__ __forceinline__ void p9_dma_third(const unsigned char* const (&rowp)[4]  , unsigned ringaddr, int t, unsigned buf) {
#pragma unroll
    for (int j = 0; j < 4; ++j) glds16(rowp[j] + 256 * t, (unsigned)__builtin_amdgcn_readfirstlane((int)(ringaddr + buf * 4096u + (unsigned)j * 1024u)));
}
__device__ __forceinline__ void p9_rowptrs(const unsigned char* (&rowp)[4], const LAS unsigned* list, const unsigned char* U6, int batch, int lane) {
#pragma unroll
    for (int j = 0; j < 4; ++j) { const int row = 4 * j + (lane >> 4); const unsigned ent = list[batch * 16 + row];
        rowp[j] = U6 + (size_t)(ent & 0x3fffu) * 512 + 16 * ((lane & 15) ^ row); }
}
typedef int i32x8 __attribute__((ext_vector_type(8)));
template <int M> __device__ __forceinline__ void p9_mma_fp4(f32x4& acc, const LAS unsigned char* ringp, const i32x8 (&B)[8], unsigned hb0, int fr, int fq) {
    const u32x4 g = *(const LAS u32x4*)(ringp + (((hb0 + (unsigned)(M >> 2)) & 3u) << 12) + fr * 256 + ((((unsigned)(4 * (M & 3) + fq)) ^ (unsigned)fr) << 4));
    const i32x8 a = {(int)g.x, (int)g.y, (int)g.z, (int)g.w, 0, 0, 0, 0};
    acc = __builtin_amdgcn_mfma_scale_f32_16x16x128_f8f6f4(a, B[M], acc, 4  , 0  , 0, 0x7f7f7f7f, 0, 0x7f7f7f7f);
}
__device__ __forceinline__ void p9_rowptrs_q(const unsigned char* (&rowp)[2], const LAS unsigned* list, const unsigned char* U4, int batch, int lane) {
#pragma unroll
    for (int j = 0; j < 2; ++j) { const int row = 8 * j + (lane >> 3); const unsigned ent = list[batch * 16 + row];
        rowp[j] = U4 + (size_t)(ent & 0x3fffu) * 512 + 16 * ((lane & 7) ^ ((row >> 1) & 7)); }
}
__device__ __forceinline__ void p9_dma_quarter(const unsigned char* const (&rowp)[2], int q, unsigned bufaddr  ) {
#pragma unroll
    for (int j = 0; j < 2; ++j) glds16(rowp[j] + 128 * q, (unsigned)__builtin_amdgcn_readfirstlane((int)(bufaddr + (unsigned)j * 1024u)));
}
template <int M> __device__ __forceinline__ void p9_mma_q(f32x4& acc, const LAS unsigned char* bufp  , unsigned lofs  , const i32x8 (&B)[8]) {
    const u32x4 g = *(const LAS u32x4*)(bufp + lofs);
    const i32x8 a = {(int)g.x, (int)g.y, (int)g.z, (int)g.w, 0, 0, 0, 0};
    acc = __builtin_amdgcn_mfma_scale_f32_16x16x128_f8f6f4(a, B[M], acc, 4  , 0  , 0, 0x7f7f7f7f, 0, 0x7f7f7f7f);
}
__device__ __forceinline__ void p9_extract(const f32x4& acc, const LAS unsigned* list, LAS float* stage, LAS bf16_t* actl, int n0, int fr, int fq) {
    *(LAS f32x4*)(stage + fr * 16 + 4 * fq) = acc;
    const unsigned ent = list[n0 + fr]; const unsigned s_ = (ent >> 14) & 7u, idx = (ent >> 17) & 127u;
    const float val = stage[(2 * s_) * 16 + fr];
    if (fq == 0) actl[s_ * 128 + idx] = (bf16_t)(cvtpk(val, 0.f) & 0xffffu);
}

__device__ __forceinline__ void phase9_pass(const Params& p, LAS unsigned char* wl  , int tk0  , int lane) {
    const bf16_t* H = (const bf16_t*)(p.ws + WS_H);
    const unsigned char* U8 = p.ws + WS_U8; const unsigned char* V8 = p.ws + WS_V8;
    const float* SU = (const float*)(p.ws + WS_SU); const float* SV = (const float*)(p.ws + WS_SV);
    const int* EIDX = (const int*)(p.ws + WS_EIDX); const float* GATE = (const float*)(p.ws + WS_GATE);
    const float* HMAX = (const float*)(p.ws + WS_HMAX);
    const float* mod = (const float*)(p.ws + WS_MOD);
    LAS unsigned* list = (LAS unsigned*)(wl + P9_LIST);
    LAS bf16_t* actl = (LAS bf16_t*)(wl + P9_ACT);
    LAS float* stage = (LAS float*)(wl + P9_STAGE);
    LAS unsigned char* ringp = wl + P9_RING;
    LAS unsigned* cnt = (LAS unsigned*)ringp;
    LAS unsigned* off = cnt + 128;
    const int fr = lane & 15, fq = lane >> 4;
    cnt[lane] = 0u; cnt[64 + lane] = 0u;
    unsigned offA, offB;
    {
        unsigned ee[16], rk[16];
#pragma unroll
        for (int i = 0; i < 16; ++i) ee[i] = (unsigned)EIDX[(size_t)(tk0 + (i >> 1)) * 128 + 64 * (i & 1) + lane];
#pragma unroll
        for (int i = 0; i < 16; ++i) rk[i] = atomicAdd((unsigned*)&cnt[(ee[i] >> 10) * 8u + (unsigned)(i >> 1)], 1u);
        { const unsigned c0 = cnt[2 * lane], c1 = cnt[2 * lane + 1]; const unsigned c = c0 + c1; unsigned inc = c;
#pragma unroll
          for (int o = 1; o < 64; o <<= 1) { const unsigned n_ = __shfl_up(inc, o); if (lane >= o) inc += n_; }
          offA = inc - c; offB = offA + c0; off[2 * lane] = offA; off[2 * lane + 1] = offB; }
#pragma unroll
        for (int i = 0; i < 16; ++i) list[off[(ee[i] >> 10) * 8u + (unsigned)(i >> 1)] + rk[i]] = ee[i] | ((unsigned)(i >> 1) << 14) | ((unsigned)(64 * (i & 1) + lane) << 17);
    }
    asm volatile("" ::: "memory");
    i32x8 B[8];
    {
        const int slot = fr >> 1;
        const bf16_t* hrow = H + (size_t)(tk0 + slot) * DM + 16 * fq;
        const float mx = HMAX[tk0 + slot];
        const float hs = mx > 0.f ? 224.f / mx : 1.f;
        const bool lo_part = (fr & 1) != 0;
#pragma unroll
        for (int mg = 0; mg < 4; ++mg) {
            u32x4 hv[2][4];
#pragma unroll
            for (int mm = 0; mm < 2; ++mm)
#pragma unroll
                for (int c = 0; c < 4; ++c) hv[mm][c] = *(const u32x4*)(hrow + 128 * (2 * mg + mm) + 64 * (c >> 1) + 8 * (c & 1));
            asm volatile("" ::: "memory");
#pragma unroll
            for (int mm = 0; mm < 2; ++mm) {
                i32x8 w;
#pragma unroll
                for (int c = 0; c < 4; ++c) { const u32x4 a = hv[mm][c];
                    w[2 * c] = (int)pk4_fp8(bflo(a.x) * hs, bfhi(a.x) * hs, bflo(a.y) * hs, bfhi(a.y) * hs);
                    w[2 * c + 1] = (int)pk4_fp8(bflo(a.z) * hs, bfhi(a.z) * hs, bflo(a.w) * hs, bfhi(a.w) * hs); }
                const i32x8 wz = {0, 0, 0, 0, 0, 0, 0, 0};
                B[2 * mg + mm] = lo_part ? wz : w;
            }
        }
    }
    {
        __builtin_amdgcn_s_waitcnt(0);
        const unsigned ringaddr = (unsigned)__builtin_amdgcn_readfirstlane((int)(unsigned)(uintptr_t)ringp);
        const unsigned lofs0 = (unsigned)(fr * 128 + (((unsigned)fq ^ (unsigned)((fr >> 1) & 7)) << 4)), lofs1 = (unsigned)(fr * 128 + (((unsigned)(4 + fq) ^ (unsigned)((fr >> 1) & 7)) << 4));
        const unsigned char* row1[2]; const unsigned char* row2[2];
        p9_rowptrs_q(row2, list, U8, 0, lane); p9_rowptrs_q(row1, list, U8, 1, lane);
        p9_dma_quarter(row2, 0, ringaddr); p9_dma_quarter(row2, 1, ringaddr + 2048u); p9_dma_quarter(row2, 2, ringaddr + 4096u); p9_dma_quarter(row2, 3, ringaddr + 6144u); p9_dma_quarter(row1, 0, ringaddr + 8192u);
        unsigned rb = 0u, wb = 5u * 2048u;
#define P9_UQ(Q, ROWS, QN) do { \
            asm volatile("s_waitcnt vmcnt(8)" ::: "memory"); \
            p9_mma_q<2 * (Q)>(acc, ringp + rb, lofs0, B); p9_mma_q<2 * (Q) + 1>(acc, ringp + rb, lofs1, B); \
            asm volatile("s_waitcnt lgkmcnt(0)" ::: "memory"); \
            p9_dma_quarter(ROWS, (QN), ringaddr + wb); \
            rb = rb + 2048u == 6u * 2048u ? 0u : rb + 2048u; wb = wb + 2048u == 6u * 2048u ? 0u : wb + 2048u; \
        } while (0)
#pragma unroll 1
        for (int b = 0; b < P9_NBATCH; ++b) {
            f32x4 acc = (f32x4){0.f, 0.f, 0.f, 0.f};
            p9_rowptrs_q(row2, list, U8, b + 2 < P9_NBATCH ? b + 2 : P9_NBATCH - 1, lane);
            P9_UQ(0, row1, 1); P9_UQ(1, row1, 2); P9_UQ(2, row1, 3); P9_UQ(3, row2, 0);
            p9_extract(acc, list, stage, actl, 16 * b, fr, fq);
            row1[0] = row2[0]; row1[1] = row2[1];
        }
#undef P9_UQ
        asm volatile("s_waitcnt vmcnt(0)" ::: "memory");
    }
    float sainv[8];
    {
        float av[16]; unsigned en[16]; float amax[8] = {0.f, 0.f, 0.f, 0.f, 0.f, 0.f, 0.f, 0.f};
#pragma unroll
        for (int k = 0; k < 16; ++k) {
            const unsigned ent = list[k * 64 + lane]; const unsigned e = ent & 0x3fffu, s_ = (ent >> 14) & 7u, idx = (ent >> 17) & 127u;
            const float d = __uint_as_float((unsigned)actl[s_ * 128 + idx] << 16);
            const float g = GATE[(size_t)(tk0 + s_) * 128 + idx], hi_ = HMAX[tk0 + s_] * (1.f / 224.f);
            av[k] = gelu_tanh(d * (SU[e] * hi_)) * (g * SV[e]); en[k] = ent;
#pragma unroll
            for (int q = 0; q < 8; ++q) amax[q] = fmaxf(amax[q], s_ == (unsigned)q ? fabsf(av[k]) : 0.f);
        }
        float sa[8];
#pragma unroll
        for (int q = 0; q < 8; ++q) { float m = amax[q];
#pragma unroll
            for (int o = 1; o < 64; o <<= 1) m = fmaxf(m, __shfl_xor(m, o));
            sa[q] = m > 0.f ? 224.f / m : 1.f; sainv[q] = m > 0.f ? m * (1.f / 224.f) : 1.f; }
        asm volatile("s_waitcnt lgkmcnt(0)" ::: "memory");
#pragma unroll
        for (int k = 0; k < 16; ++k) { const unsigned s_ = (en[k] >> 14) & 7u;
            float sc = sa[0];
#pragma unroll
            for (int q = 1; q < 8; ++q) sc = s_ == (unsigned)q ? sa[q] : sc;
            const unsigned b8 = (unsigned)__builtin_amdgcn_cvt_pk_fp8_f32(av[k] * sc, 0.f, 0, false) & 0xffu;
            list[k * 64 + lane] = (en[k] & 0x00ffffffu) | (b8 << 24); }
    }
    {
        LAS unsigned char* vring = wl + P9_VRING;
        f32x16 y[8];
#pragma unroll
        for (int s_ = 0; s_ < 8; ++s_)
#pragma unroll
            for (int r = 0; r < 16; ++r) y[s_][r] = 0.f;
        __builtin_amdgcn_s_waitcnt(0);
        const unsigned ringaddr = (unsigned)__builtin_amdgcn_readfirstlane((int)(unsigned)(uintptr_t)vring);
        const int j5 = lane & 31, kg = lane >> 5;
        const unsigned lo16 = 16u * (unsigned)j5;
        unsigned am[4];
#pragma unroll
        for (int d = 0; d < 4; ++d) am[d] = (kg == (j5 >> 4) && d == ((j5 & 15) >> 2)) ? (0xffu << (8 * (j5 & 3))) : 0u;
#define P9_VISSUE2E(m, ENT) do { const unsigned off_ = (((ENT) & 0x3fffu) << 9) | lo16; \
            const unsigned dst_ = (unsigned)__builtin_amdgcn_readfirstlane((int)(ringaddr + ((((unsigned)(m)) & 31u) << 9))); \
            asm volatile("s_mov_b32 m0, %2\n\ts_nop 0\n\tglobal_load_lds_dwordx4 %0, %1" :: "v"(off_), "s"(V8), "s"(dst_) : "memory", "m0"); } while (0)
#pragma unroll 1
        for (int m_ = 0; m_ < 32; m_ += 2) P9_VISSUE2E(m_, list[m_ + kg]);
        int n = 0, iss = 32;
        asm volatile("s_waitcnt vmcnt(14)" ::: "memory");
        u32x4 bq = *(const LAS u32x4*)(vring + (((unsigned)kg) << 9) + lo16);
        unsigned a0q = list[0], a1q = list[1], enq = list[32 + kg];
#define P9_VPAIR(S, TWO) do { \
            asm volatile("s_waitcnt lgkmcnt(0)" ::: "memory");        \
            const int nn_ = n + ((TWO) ? 2 : 1); const bool doi_ = iss <= nn_ + 30; \
            const unsigned a0_ = __builtin_amdgcn_perm(a0q, a0q, 0x03030303u), a1_ = (TWO) ? __builtin_amdgcn_perm(a1q, a1q, 0x03030303u) : 0u;     \
            const i32x8 am_ = {(int)(a0_ & am[0]), (int)(a0_ & am[1]), (int)(a0_ & am[2]), (int)(a0_ & am[3]), (int)(a1_ & am[0]), (int)(a1_ & am[1]), (int)(a1_ & am[2]), (int)(a1_ & am[3])}; \
            const i32x8 bm_ = {(int)bq.x, (int)bq.y, (int)bq.z, (int)bq.w, 0, 0, 0, 0}; \
            y[S] = __builtin_amdgcn_mfma_scale_f32_32x32x64_f8f6f4(am_, bm_, y[S], 0  , 4  , 0, 0x7f7f7f7f, 0, 0x7f7f7f7f); \
            if (doi_) { P9_VISSUE2E(iss, enq); iss += 2; } \
            asm volatile("s_waitcnt vmcnt(13)" ::: "memory"); \
            bq = *(const LAS u32x4*)(vring + ((((unsigned)(nn_ + kg)) & 31u) << 9) + lo16); \
            a0q = list[nn_]; a1q = list[nn_ + 1]; \
            { const int mi_ = iss + kg; enq = list[mi_ < P9_NENT ? mi_ : P9_NENT - 1]; } \
        } while (0)
#define P9_VSEG(S, END) do { const int end_ = (END); \
            _Pragma("unroll 1") for (; n + 1 < end_; n += 2) P9_VPAIR(S, true); \
            if (n < end_) { P9_VPAIR(S, false); ++n; } } while (0)
#pragma unroll 1
        for (int b = 0; b < 16; ++b) {
            P9_VSEG(0, __builtin_amdgcn_readlane((int)offB, 4 * b));
            P9_VSEG(1, __builtin_amdgcn_readlane((int)offA, 4 * b + 1));
            P9_VSEG(2, __builtin_amdgcn_readlane((int)offB, 4 * b + 1));
            P9_VSEG(3, __builtin_amdgcn_readlane((int)offA, 4 * b + 2));
            P9_VSEG(4, __builtin_amdgcn_readlane((int)offB, 4 * b + 2));
            P9_VSEG(5, __builtin_amdgcn_readlane((int)offA, 4 * b + 3));
            P9_VSEG(6, __builtin_amdgcn_readlane((int)offB, 4 * b + 3));
            P9_VSEG(7, (b < 15) ? __builtin_amdgcn_readlane((int)offA, (4 * b + 4) & 63) : P9_NENT);
        }
        asm volatile("s_waitcnt vmcnt(0)" ::: "memory");
        const int bsel = tk0 / SEQ; const int eo = 32 * j5 + 4 * kg;
        f32x4 gtg[4];
#pragma unroll
        for (int u = 0; u < 4; ++u) gtg[u] = *(const f32x4*)(mod + bsel * NMOD + 5 * DM + 8 * u + eo) * *(const f32x4*)(p.g_post_ffn + 8 * u + eo);
#pragma unroll
        for (int s_ = 0; s_ < 8; ++s_) {
            const int t_ = tk0 + s_;
            f32x4 yy[4];
            float ss = 0.f;
#pragma unroll
            for (int u = 0; u < 4; ++u) { yy[u] = (f32x4){y[s_][4 * u], y[s_][4 * u + 1], y[s_][4 * u + 2], y[s_][4 * u + 3]} * sainv[s_]; ss += yy[u][0] * yy[u][0] + yy[u][1] * yy[u][1] + yy[u][2] * yy[u][2] + yy[u][3] * yy[u][3]; }
            const float rstd = rsqrtf(wave_sum_dpp(ss) * (1.f / DM) + RMS_EPS);
            float* orow = p.out + (size_t)t_ * DM + eo; const bf16_t* xrow = (const bf16_t*)(p.ws + WS_X1) + (size_t)t_ * DM + eo;
#pragma unroll
            for (int u = 0; u < 4; ++u) { const u32x2 xb = *(const u32x2*)(xrow + 8 * u); const f32x4 x1 = {bflo(xb.x), bfhi(xb.x), bflo(xb.y), bfhi(xb.y)}; *(f32x4*)(orow + 8 * u) = x1 + gtg[u] * (yy[u] * rstd); }
        }
        asm volatile("s_waitcnt lgkmcnt(0)" ::: "memory");
    }
}

#define XB_TMO      128
#define XB_XCNT(j)  (256  + 64 * (j))
#define XB_XSUB(j)  (1280 + 64 * (j))
#define XB_XGEN(j)  (2304 + 64 * (j))
#define XB_TOP      3328
#define XB_TOPGEN   3392
#define XCD_BAR_WORDS 3456
#define XB_SPIN_CAP (1u << 18)

__device__ __forceinline__ unsigned xb_ld(unsigned* p)              { return __hip_atomic_load(p, __ATOMIC_RELAXED, __HIP_MEMORY_SCOPE_AGENT); }
__device__ __forceinline__ unsigned xb_add(unsigned* p, unsigned v) { return __hip_atomic_fetch_add(p, v, __ATOMIC_RELAXED, __HIP_MEMORY_SCOPE_AGENT); }
__device__ __forceinline__ unsigned xb_xcc_id() { return (unsigned)__builtin_amdgcn_s_getreg((3 << 11) | 20) & 0xFu; }
#define XB_SPIN(cond, bar) do { unsigned _sp = 0; while (cond) { __builtin_amdgcn_s_sleep(1); \
    if ((++_sp & 255u) == 0u) { if (xb_ld(&(bar)[XB_TMO])) break; if (_sp > XB_SPIN_CAP) { atomicAdd(&(bar)[XB_TMO], 1u); break; } } } } while (0)

struct XcdBarrier {
    unsigned* bar; unsigned x;
    volatile LAS unsigned* st;
};

__device__ __forceinline__ XcdBarrier xcd_barrier_post(unsigned* bar, volatile LAS unsigned* st) {
    XcdBarrier b; b.bar = bar; b.x = xb_xcc_id(); b.st = st;
    if (threadIdx.x == 0) (void)xb_add(&bar[XB_XCNT(b.x)], 1u);
    return b;
}
__device__ __forceinline__ void xcd_barrier_complete(unsigned* bar, unsigned x, unsigned& nloc, unsigned& nx) {
    const unsigned G = gridDim.x * gridDim.y * gridDim.z;
    unsigned sum, cnt, mine, sp = 0u;
    for (;;) {
        sum = 0u; cnt = 0u; mine = 0u;
#pragma unroll
        for (unsigned j = 0; j < 16; ++j) { const unsigned c = xb_ld(&bar[XB_XCNT(j)]); sum += c; cnt += (c > 0u) ? 1u : 0u; mine = (j == x) ? c : mine; }
        if (sum == G) break;
        __builtin_amdgcn_s_sleep(1);
        if ((++sp & 255u) == 0u) { if (xb_ld(&bar[XB_TMO])) break; if (sp > XB_SPIN_CAP) { atomicAdd(&bar[XB_TMO], 1u); break; } }
    }
    nloc = mine > 0u ? mine : 1u; nx = cnt > 0u ? cnt : 1u;
}

__device__ __forceinline__ void xcd_barrier(const XcdBarrier& b) {
    asm volatile("s_waitcnt vmcnt(0)" ::: "memory");
    __syncthreads();
    if (threadIdx.x == 0) {
        unsigned* bar = b.bar;
        __builtin_amdgcn_s_waitcnt(0);
        unsigned nloc = b.st[0], nx = b.st[1];
        if (nloc == 0u) { xcd_barrier_complete(bar, b.x, nloc, nx); b.st[0] = nloc; b.st[1] = nx; }
        const unsigned old = xb_add(&bar[XB_XSUB(b.x)], 1u);
        const unsigned gen = old / nloc;
        if (old + 1u == (gen + 1u) * nloc) {
            __builtin_amdgcn_fence(__ATOMIC_RELEASE, "agent");
            asm volatile("s_waitcnt vmcnt(0)" ::: "memory");
            const unsigned og = xb_add(&bar[XB_TOP], 1u);
            const unsigned tg = og / nx;
            if (og + 1u == (tg + 1u) * nx) xb_add(&bar[XB_TOPGEN], 1u);
            else XB_SPIN(xb_ld(&bar[XB_TOPGEN]) == tg, bar);
            __builtin_amdgcn_fence(__ATOMIC_ACQUIRE, "agent");
            xb_add(&bar[XB_XGEN(b.x)], 1u);
            asm volatile("s_waitcnt vmcnt(0)" ::: "memory");
        } else {
            XB_SPIN(xb_ld(&bar[XB_XGEN(b.x)]) == gen, bar);
            __builtin_amdgcn_fence(__ATOMIC_ACQUIRE, "agent");
            asm volatile("s_waitcnt vmcnt(0)" ::: "memory");
        }
    }
    __syncthreads();
}


__global__ void __launch_bounds__(NTHREADS, 2) fwd_kernel(Params p) {
    extern __shared__ __attribute__((aligned(16))) unsigned char lds_raw[];
    LAS unsigned char* lds = (LAS unsigned char*)lds_raw;
    volatile LAS unsigned* bst = (volatile LAS unsigned*)(lds + LDS_BYTES - 16);
    if (threadIdx.x < 4) bst[threadIdx.x] = 0u;
    __syncthreads();
    const XcdBarrier xbar = xcd_barrier_post((unsigned*)(p.ws + WS_BAR), bst);
#define GRID_BAR() xcd_barrier(xbar)

    REPEAT(1, phase0(p, lds));
    GRID_BAR();
    REPEAT(2, phase1(p, lds));
    GRID_BAR();
    scan_kb(p, lds);
    REPEAT(3, {
        pg8::Gemm g{(const bf16_t*)(p.ws + WS_H), (const bf16_t*)(p.ws + WS_WTIN), T, NPROJ, DM};
        pg8::StaticOrder S; S.init(T, NPROJ, gridDim.x, blockIdx.x);
        pg8::EpiBf16 E{(bf16_t*)(p.ws + WS_PROJ), NPROJ, 0xC3u, C2};
        pg8::gemm_phase<pg8::EpiBf16, pg8::StaticOrder>(lds, g, S, E);
    });
    GRID_BAR();
    REPEAT(4, { fox_prepass(p); phase_swa(p, lds); });
    GRID_BAR();
    REPEAT(5, phase_fox(p, lds));
    GRID_BAR();
    REPEAT(6, {
        pg8::Gemm g{(const bf16_t*)(p.ws + WS_ATT), (const bf16_t*)(p.ws + WS_WTOUT), T, DM, DM};
        pg8::StaticOrder S; S.init(T, DM, gridDim.x, blockIdx.x);
        pg8::EpiBf16 E{(bf16_t*)(p.ws + WS_PROJ), DM, 0u, 1.f};
        pg8::gemm_phase<pg8::EpiBf16, pg8::StaticOrder>(lds, g, S, E);
    });
    GRID_BAR();
    REPEAT(7, phase6(p));
    GRID_BAR();
    REPEAT(8, {
        pg8::Gemm g{(const bf16_t*)(p.ws + WS_H), (const bf16_t*)(p.ws + WS_WTQ), T, 2048, DM};
        pg8::StaticOrder S; S.init(T, 2048, gridDim.x, blockIdx.x);
        pg8::EpiBf16 E{(bf16_t*)(p.ws + WS_PROJ), 2048, 0u, 1.f};
        pg8::gemm_phase<pg8::EpiBf16, pg8::StaticOrder>(lds, g, S, E);
    });
    GRID_BAR();
    for (int tb = blockIdx.x * 128; tb < T; tb += gridDim.x * 128) {
        REPEAT(9, { const int t8 = fresh_tid(); phase8_block(p, lds, tb + 16 * (t8 >> 6), __builtin_amdgcn_readfirstlane(t8 >> 6), t8 & 63); });
        __builtin_amdgcn_fence(__ATOMIC_RELEASE, "workgroup");
        asm volatile("s_waitcnt vmcnt(0)" ::: "memory");
        __builtin_amdgcn_fence(__ATOMIC_ACQUIRE, "workgroup");
        __syncthreads();
#pragma unroll 1
        for (int i = 0; i < 2; ++i) { const int t9 = fresh_tid(); phase9_pass(p, lds + (t9 >> 6) * P9_WAVE_LDS, tb + 16 * (t9 >> 6) + 8 * i, t9 & 63); }
    }
}

extern "C" void kernel_launch(void* const* d_in, const int* in_sizes, int n_in, void* d_out, int out_size, void* d_ws, size_t ws_size, hipStream_t stream) {
    static int grid_blocks = 0;
    if (grid_blocks == 0) {
        if (n_in != 16 || out_size != T * DM || ws_size < WS_END) { fprintf(stderr, "kernel_launch: unexpected shapes (n_in %d out %d ws %zu)\n", n_in, out_size, ws_size); grid_blocks = -1; return; }
        int dev = 0, cus = 0, per_cu = 0;
        (void)hipGetDevice(&dev);
        (void)hipDeviceGetAttribute(&cus, hipDeviceAttributeMultiprocessorCount, dev);
        (void)hipFuncSetAttribute((const void*)fwd_kernel, hipFuncAttributeMaxDynamicSharedMemorySize, LDS_BYTES);
        (void)hipOccupancyMaxActiveBlocksPerMultiprocessor(&per_cu, (const void*)fwd_kernel, NTHREADS, LDS_BYTES);
        if (per_cu < 1) { fprintf(stderr, "kernel_launch: occupancy query says %d blocks per CU\n", per_cu); per_cu = 1; }
        grid_blocks = cus;
        fprintf(stderr, "kernel_launch: grid %d (cus %d, per_cu %d)\n", grid_blocks, cus, per_cu);
    }
    if (grid_blocks < 0) return;
    Params p{};
    p.x = (const float*)d_in[0]; p.c = (const float*)d_in[1]; p.w_ada = (const float*)d_in[2]; p.b_ada = (const float*)d_in[3];
    p.g_pre_mix = (const float*)d_in[4]; p.g_post_mix = (const float*)d_in[5]; p.g_pre_ffn = (const float*)d_in[6]; p.g_post_ffn = (const float*)d_in[7];
    p.w_in = (const float*)d_in[8]; p.b_fgate = (const float*)d_in[9]; p.swa_sinks = (const float*)d_in[10]; p.w_out = (const float*)d_in[11];
    p.w_query = (const float*)d_in[12]; p.sub_keys = (const float*)d_in[13]; p.w_u = (const float*)d_in[14]; p.w_v = (const float*)d_in[15];
    p.out = (float*)d_out; p.ws = (unsigned char*)d_ws;
    (void)hipMemsetAsync((unsigned char*)d_ws + WS_BAR, 0, 16384, stream);
    void* args[] = {&p};
    hipError_t e = hipLaunchCooperativeKernel((void*)fwd_kernel, dim3(grid_blocks), dim3(NTHREADS), args, LDS_BYTES, stream);
    if (e != hipSuccess) fprintf(stderr, "kernel_launch: cooperative launch failed: %s (grid %d)\n", hipGetErrorString(e), grid_blocks);
}
```

```cpp
#include <hip/hip_runtime.h>
#include <hip/hip_cooperative_groups.h>
#include <cstdio>
#include <cstdint>
namespace cg = cooperative_groups;

#define LAS __attribute__((address_space(3)))
typedef unsigned short bf16_t;
typedef short bf16x8 __attribute__((ext_vector_type(8)));
typedef short s16x4 __attribute__((ext_vector_type(4)));
typedef float f32x4 __attribute__((ext_vector_type(4)));
typedef float f32x16 __attribute__((ext_vector_type(16)));
typedef unsigned u32x4 __attribute__((ext_vector_type(4)));
typedef unsigned u32x2 __attribute__((ext_vector_type(2)));
typedef float f32x2_t __attribute__((ext_vector_type(2)));
typedef __bf16 bf16x2_t __attribute__((ext_vector_type(2)));

constexpr int BATCH = 4, SEQ = 8192, DM = 1024, T = BATCH * SEQ;
constexpr int NPROJ = 2304, INW = 2312;
constexpr int NMOD = 6 * DM;
constexpr float RMS_EPS = 1e-6f;
constexpr float LOG2E = 1.4426950408889634f;
constexpr float C2 = 0.125f * LOG2E;
constexpr float NEGBIG = -1e30f;

constexpr size_t MiB = 1u << 20;
constexpr size_t WS_MOD = 0, WS_WF = 128 * 1024, WS_KT = 256 * 1024  , WS_BAR = 512 * 1024  , WS_HMAX = 640 * 1024  , WS_LS = 1 * MiB, WS_KB = 2 * MiB;
constexpr size_t WS_WTIN = 4 * MiB, WS_WTOUT = 10 * MiB, WS_WTQ = 12 * MiB, WS_SK = 16 * MiB;
constexpr size_t WS_U8 = 32 * MiB, WS_V8 = 48 * MiB, WS_SU = 64 * MiB, WS_SV = 64 * MiB + 65536, WS_H = 96 * MiB, WS_ATT = 160 * MiB, WS_PROJ = 224 * MiB;
constexpr size_t WS_EIDX = 160 * MiB, WS_GATE = 176 * MiB  , WS_X1 = 352 * MiB, WS_END = 480 * MiB;

constexpr int NTHREADS = 512, NWAVES = 8;
#define REP_PHASE 0
#define REPEAT(k, ...) do { __VA_ARGS__; if (REP_PHASE == (k)) { __syncthreads(); __VA_ARGS__; } } while (0)
constexpr int LDS_BYTES = 163840;

__device__ __forceinline__ unsigned cvtpk(float lo, float hi) { f32x2_t v = {lo, hi}; bf16x2_t b = __builtin_convertvector(v, bf16x2_t); return __builtin_bit_cast(unsigned, b); }
__device__ __forceinline__ float bflo(unsigned w) { return __uint_as_float(w << 16); }
__device__ __forceinline__ float bfhi(unsigned w) { return __uint_as_float(w & 0xffff0000u); }
__device__ __forceinline__ float wave_sum(float v) {
#pragma unroll
    for (int o = 1; o < 64; o <<= 1) v += __shfl_xor(v, o);
    return v;
}
__device__ __forceinline__ float vmaxf(float a, float b) { float r; asm("v_max_f32_e32 %0, %1, %2" : "=v"(r) : "v"(a), "v"(b)); return r; }
__device__ __forceinline__ float vminf(float a, float b) { float r; asm("v_min_f32_e32 %0, %1, %2" : "=v"(r) : "v"(a), "v"(b)); return r; }
__device__ __forceinline__ int fresh_tid() { int t = threadIdx.x; asm volatile("" : "+v"(t)); return t; }
__device__ __forceinline__ int crow(int r, int hi) { return (r & 3) + 8 * (r >> 2) + 4 * hi; }

namespace pg8 {
constexpr int BM = 256, BK = 64, HALF = 128, HTB = HALF * BK * 2, STAGE_BYTES = 8 * HTB, NXCD = 8, WGM = 8;
__host__ __device__ __forceinline__ int lds_byte(int r, int c) { const int st = (r >> 4) * 2 + (c >> 5), rr = r & 15, cc = c & 31, ob = rr * 64 + cc * 2; return st * 1024 + (ob ^ (((ob >> 9) & 1) << 5)); }
__host__ __device__ __forceinline__ void stage_rc(int b, int& R, int& C) { const int st = b / 1024, sb = b % 1024, swz = sb ^ (((sb >> 9) & 1) << 5); R = (st >> 1) * 16 + swz / 64; C = (st & 1) * 32 + (swz % 64) / 2; }
__host__ __device__ __forceinline__ int perm32(int rho) { const int n = rho >> 4, i = rho & 15; return 8 * (i >> 2) + 4 * n + (i & 3); }
struct Unit { int pm, pn; };
struct Gemm { const bf16_t* A; const bf16_t* Bt; int M, N, K; };
struct StaticOrder {
    int nM, nN, nwg, G, c;
    __device__ void init(int M, int N, int G_, int c_) { nM = M / BM; nN = N / BM; nwg = nM * nN; G = G_; c = c_; }
    __device__ bool next(int i, Unit& u) const {
        const long L = (long)i * G + c; if (L >= nwg) return false;
        int wgid = (int)L; { const int q = nwg / NXCD, r = nwg % NXCD, xcd = wgid % NXCD, off = wgid / NXCD; wgid = (xcd < r ? xcd * (q + 1) : r * (q + 1) + (xcd - r) * q) + off; }
        const int nig = WGM * nN, gid = wgid / nig, fm = gid * WGM, gsz = (nM - fm) < WGM ? (nM - fm) : WGM;
        u.pm = fm + ((wgid % nig) % gsz); u.pn = (wgid % nig) / gsz; return true;
    }
};
struct EpiBf16 {
    static constexpr bool PERM = true;
    bf16_t* O; int ldc; unsigned scale_mask; float sc;
    __device__ __forceinline__ void operator()(const f32x4 (&acc)[2][2][4][2], const Unit& u, int wr, int wc, int fr, int fq) const {
        const int row0 = u.pm * BM + wr * 64 + fr; const int col0 = u.pn * BM + wc * 32 + 8 * fq;
        const float s = ((scale_mask >> u.pn) & 1u) ? sc : 1.f;
#pragma unroll
        for (int ai = 0; ai < 2; ++ai)
#pragma unroll
            for (int m = 0; m < 4; ++m) { bf16_t* rowp = O + (size_t)(row0 + ai * HALF + m * 16) * ldc + col0;
#pragma unroll
                for (int bj = 0; bj < 2; ++bj) { const f32x4 v0 = acc[ai][bj][m][0] * s, v1 = acc[ai][bj][m][1] * s;
                    u32x4 w; w.x = cvtpk(v0[0], v0[1]); w.y = cvtpk(v0[2], v0[3]); w.z = cvtpk(v1[0], v1[1]); w.w = cvtpk(v1[2], v1[3]);
                    *(u32x4*)(rowp + bj * HALF) = w; } }
    }
};

template <class Epi, class Sched>
__device__ __forceinline__ void gemm_phase(LAS unsigned char* lds, const Gemm g, const Sched& S, const Epi& E) {
    const int tid = fresh_tid(), wid = __builtin_amdgcn_readfirstlane(tid >> 6), lane = tid & 63, wr = wid >> 2, wc = wid & 3, fr = lane & 15, fq = lane >> 4;
    const int K = g.K, nt = K / BK;
    unsigned voffA[2], voffB[2];
#pragma unroll
    for (int i = 0; i < 2; ++i) { int R, C; stage_rc(tid * 16 + i * 8192, R, C); const int Rb = Epi::PERM ? ((R & ~31) + perm32(R & 31)) : R;
        voffA[i] = (unsigned)(R * K + C) * 2u; voffB[i] = (unsigned)(Rb * K + C) * 2u; }
    const size_t kstep = (size_t)(BK * 2);
    const size_t hstep = (size_t)HALF * K * 2;
    const size_t tstep = 2 * hstep;
    const unsigned ldsw = (unsigned)wid * 1024u;
    const int aoff = lds_byte(wr * 64 + fr, fq * 8), boff = lds_byte(wc * 32 + fr, fq * 8);
#define PG8_SA(b, h) (((b) * 2 + (h)) * HTB)
#define PG8_SB(b, h) ((4 + (b) * 2 + (h)) * HTB)
#define PG8_STAGE(bufoff, gbase, voff) do { _Pragma("unroll") for (int _i = 0; _i < 2; ++_i) \
        __builtin_amdgcn_global_load_lds((const unsigned*)((const char*)(gbase) + (voff)[_i]), (LAS unsigned*)(lds + (bufoff) + ldsw + _i * 8192), 16, 0, 0); } while (0)
#define PG8_LDA(dst, b, h) do { _Pragma("unroll") for (int m = 0; m < 4; ++m) _Pragma("unroll") for (int k = 0; k < 2; ++k) dst[m][k] = *(const LAS bf16x8*)(lds + PG8_SA(b, h) + aoff + m * 2048 + k * 1024); } while (0)
#define PG8_LDB(dst, b, h) do { _Pragma("unroll") for (int n = 0; n < 2; ++n) _Pragma("unroll") for (int k = 0; k < 2; ++k) dst[n][k] = *(const LAS bf16x8*)(lds + PG8_SB(b, h) + boff + n * 2048 + k * 1024); } while (0)
#define PG8_MMA(ai, bj, At, Bt) do { __builtin_amdgcn_s_setprio(1); _Pragma("unroll") for (int m = 0; m < 4; ++m) _Pragma("unroll") for (int n = 0; n < 2; ++n) _Pragma("unroll") for (int k = 0; k < 2; ++k) \
        acc[ai][bj][m][n] = __builtin_amdgcn_mfma_f32_16x16x32_bf16(Bt[n][k], At[m][k], acc[ai][bj][m][n], 0, 0, 0); __builtin_amdgcn_s_setprio(0); } while (0)
#define PG8_WAIT_V(n) asm volatile("s_waitcnt vmcnt(" #n ")" ::: "memory")
#define PG8_WAIT_L(n) asm volatile("s_waitcnt lgkmcnt(" #n ")" ::: "memory")
#define PG8_BAR __builtin_amdgcn_s_barrier()
#define PG8_SCHED __builtin_amdgcn_sched_barrier(0)
    Unit cur, nxt; int ui = 0;
    if (!S.next(0, cur)) return;
    f32x4 acc[2][2][4][2];
#pragma unroll
    for (int a = 0; a < 2; ++a)
#pragma unroll
        for (int b = 0; b < 2; ++b)
#pragma unroll
            for (int m = 0; m < 4; ++m)
#pragma unroll
                for (int n = 0; n < 2; ++n) acc[a][b][m][n] = (f32x4){0.f, 0.f, 0.f, 0.f};
    bf16x8 At[4][2], B0[2][2], B1[2][2];
    const char* cA = (const char*)g.A + (size_t)cur.pm * tstep; const char* cB = (const char*)g.Bt + (size_t)cur.pn * tstep;
    PG8_STAGE(PG8_SB(0, 0), cB, voffB); PG8_STAGE(PG8_SA(0, 0), cA, voffA); PG8_STAGE(PG8_SB(0, 1), cB + hstep, voffB); PG8_STAGE(PG8_SA(0, 1), cA + hstep, voffA);
    if (wr == 1) PG8_BAR;
    PG8_WAIT_V(4); PG8_BAR;
    PG8_STAGE(PG8_SB(1, 0), cB + kstep, voffB); PG8_STAGE(PG8_SA(1, 0), cA + kstep, voffA); PG8_STAGE(PG8_SB(1, 1), cB + hstep + kstep, voffB);
    PG8_WAIT_V(6); PG8_BAR;
    for (;;) {
        const bool has_next = S.next(ui + 1, nxt);
        const char* nA = has_next ? (const char*)g.A + (size_t)nxt.pm * tstep : cA; const char* nB = has_next ? (const char*)g.Bt + (size_t)nxt.pn * tstep : cB;
        for (int t = 0; t < nt; t += 2) {
            const bool last = (t == nt - 2);
            const char* a1 = cA + (size_t)(t + 1) * kstep;
            const char* a2 = last ? nA : cA + (size_t)(t + 2) * kstep; const char* b2 = last ? nB : cB + (size_t)(t + 2) * kstep;
            const char* a3 = a2 + kstep; const char* b3 = b2 + kstep;
            PG8_LDB(B0, 0, 0); PG8_SCHED; PG8_LDA(At, 0, 0); PG8_STAGE(PG8_SA(1, 1), a1 + hstep, voffA);
            PG8_WAIT_L(8); PG8_BAR; PG8_WAIT_L(0); PG8_MMA(0, 0, At, B0); PG8_BAR; PG8_SCHED;
            PG8_LDB(B1, 0, 1); PG8_STAGE(PG8_SB(0, 0), b2, voffB);
            PG8_BAR; PG8_WAIT_L(0); PG8_MMA(0, 1, At, B1); PG8_BAR;
            PG8_LDA(At, 0, 1); PG8_STAGE(PG8_SA(0, 0), a2, voffA);
            PG8_BAR; PG8_WAIT_L(0); PG8_MMA(1, 0, At, B0); PG8_BAR; PG8_SCHED;
            PG8_STAGE(PG8_SB(0, 1), b2 + hstep, voffB);
            PG8_WAIT_V(6); PG8_BAR; PG8_MMA(1, 1, At, B1); PG8_BAR;
            PG8_LDB(B0, 1, 0); PG8_SCHED; PG8_LDA(At, 1, 0); PG8_STAGE(PG8_SA(0, 1), a2 + hstep, voffA);
            PG8_WAIT_L(8); PG8_BAR; PG8_WAIT_L(0); PG8_MMA(0, 0, At, B0); PG8_BAR; PG8_SCHED;
            PG8_LDB(B1, 1, 1); PG8_STAGE(PG8_SB(1, 0), b3, voffB);
            PG8_BAR; PG8_WAIT_L(0); PG8_MMA(0, 1, At, B1); PG8_BAR;
            PG8_LDA(At, 1, 1); PG8_STAGE(PG8_SA(1, 0), a3, voffA);
            PG8_BAR; PG8_WAIT_L(0); PG8_MMA(1, 0, At, B0); PG8_BAR; PG8_SCHED;
            PG8_STAGE(PG8_SB(1, 1), b3 + hstep, voffB);
            PG8_WAIT_V(6); PG8_BAR; PG8_MMA(1, 1, At, B1); PG8_BAR;
        }
        E(acc, cur, wr, wc, fr, fq);
        if (!has_next) break;
#pragma unroll
        for (int a = 0; a < 2; ++a)
#pragma unroll
            for (int b = 0; b < 2; ++b)
#pragma unroll
                for (int m = 0; m < 4; ++m)
#pragma unroll
                    for (int n = 0; n < 2; ++n) acc[a][b][m][n] = (f32x4){0.f, 0.f, 0.f, 0.f};
        cur = nxt; cA = nA; cB = nB; ++ui;
    }
    PG8_WAIT_V(0);
    if (wr == 0) PG8_BAR;
    PG8_BAR;
#undef PG8_SA
#undef PG8_SB
#undef PG8_STAGE
#undef PG8_LDA
#undef PG8_LDB
#undef PG8_MMA
#undef PG8_WAIT_V
#undef PG8_WAIT_L
#undef PG8_BAR
#undef PG8_SCHED
}
}

struct Params {
    const float *x, *c, *w_ada, *b_ada, *g_pre_mix, *g_post_mix, *g_pre_ffn, *g_post_ffn, *w_in, *b_fgate, *swa_sinks, *w_out, *w_query, *sub_keys, *w_u, *w_v;
    float* out; unsigned char* ws;
};

__device__ __forceinline__ void phase0(const Params& p, LAS unsigned char* lds) {
    const int tid = fresh_tid();
    float* mod = (float*)(p.ws + WS_MOD);
    if (blockIdx.x < NMOD / 32) {
        LAS float* sc = (LAS float*)lds;
        LAS float* red = (LAS float*)(lds + 16384);
        for (int i = tid; i < BATCH * DM; i += NTHREADS) { const float cv = p.c[i]; sc[i] = cv / (1.f + __expf(-cv)); }
        __syncthreads();
        const int cl = tid & 31, ks = tid >> 5, col = blockIdx.x * 32 + cl;
        float a0 = 0.f, a1 = 0.f, a2 = 0.f, a3 = 0.f;
#pragma unroll 32
        for (int k = ks * 64; k < ks * 64 + 64; ++k) { const float w = p.w_ada[(size_t)k * NMOD + col]; a0 += sc[k] * w; a1 += sc[DM + k] * w; a2 += sc[2 * DM + k] * w; a3 += sc[3 * DM + k] * w; }
        red[(ks * 4 + 0) * 32 + cl] = a0; red[(ks * 4 + 1) * 32 + cl] = a1; red[(ks * 4 + 2) * 32 + cl] = a2; red[(ks * 4 + 3) * 32 + cl] = a3;
        __syncthreads();
        if (tid < 128) { const int b = tid >> 5, c2 = tid & 31; float s = 0.f;
#pragma unroll
            for (int k = 0; k < 16; ++k) s += red[(k * 4 + b) * 32 + c2];
            mod[b * NMOD + blockIdx.x * 32 + c2] = s + p.b_ada[blockIdx.x * 32 + c2]; }
        __syncthreads();
    }
    const size_t gt = (size_t)blockIdx.x * NTHREADS + tid, ng = (size_t)gridDim.x * NTHREADS;
    {
        const int lane = tid & 63, gw = blockIdx.x * NWAVES + (tid >> 6), ngw = gridDim.x * NWAVES;
        unsigned char* U6 = p.ws + WS_U8; unsigned char* V8 = p.ws + WS_V8; float* SU = (float*)(p.ws + WS_SU); float* SV = (float*)(p.ws + WS_SV);
        for (int r = gw; r < 8192 + 8192; r += ngw) {
            const bool isv = r < 8192;
            const int e = 2 * (isv ? r : r - 8192) + (lane >> 5), l32 = lane & 31;
            const float* src = (isv ? p.w_v : p.w_u) + (size_t)e * DM + 32 * l32;
            f32x4 q[8]; float mx = 0.f;
#pragma unroll
            for (int k = 0; k < 8; ++k) { q[k] = *(const f32x4*)(src + 4 * k);
#pragma unroll
                for (int i = 0; i < 4; ++i) mx = fmaxf(mx, fabsf(q[k][i])); }
#pragma unroll
            for (int o = 1; o < 32; o <<= 1) mx = fmaxf(mx, __shfl_xor(mx, o));
            const float sc = mx > 0.f ? 6.f / mx : 1.f, isc = mx > 0.f ? mx * (1.f / 6.f) : 1.f;
            u32x4 w;
#pragma unroll
            for (int d = 0; d < 4; ++d) { unsigned t_ = 0u;
                t_ = __builtin_amdgcn_cvt_scalef32_pk_fp4_f32(t_, q[2 * d][0] * sc, q[2 * d][1] * sc, 1.0f, 0);
                t_ = __builtin_amdgcn_cvt_scalef32_pk_fp4_f32(t_, q[2 * d][2] * sc, q[2 * d][3] * sc, 1.0f, 1);
                t_ = __builtin_amdgcn_cvt_scalef32_pk_fp4_f32(t_, q[2 * d + 1][0] * sc, q[2 * d + 1][1] * sc, 1.0f, 2);
                t_ = __builtin_amdgcn_cvt_scalef32_pk_fp4_f32(t_, q[2 * d + 1][2] * sc, q[2 * d + 1][3] * sc, 1.0f, 3);
                w[d] = t_; }
            *(u32x4*)((isv ? V8 : U6) + (size_t)e * 512 + 16 * l32) = w;
            if (l32 == 0) (isv ? SV : SU)[e] = isc;
        }
    }
    {
        bf16_t* SK = (bf16_t*)(p.ws + WS_SK); const size_t n8 = 16 * 128 * 128 / 8;
        for (size_t i = gt; i < n8; i += ng) { const float* src = p.sub_keys + i * 8; const f32x4 a = *(const f32x4*)src, b = *(const f32x4*)(src + 4);
            u32x4 w; w.x = cvtpk(a[0], a[1]); w.y = cvtpk(a[2], a[3]); w.z = cvtpk(b[0], b[1]); w.w = cvtpk(b[2], b[3]); *(u32x4*)(SK + i * 8) = w; }
    }
    {
        bf16_t* WTI = (bf16_t*)(p.ws + WS_WTIN); bf16_t* WTO = (bf16_t*)(p.ws + WS_WTOUT); bf16_t* WTQ = (bf16_t*)(p.ws + WS_WTQ);
        const size_t nI = (size_t)NPROJ * 128, nO = (size_t)1024 * 128, nQ = (size_t)2048 * 128;
        for (size_t i0_ = gt; i0_ < nI + nO + nQ; i0_ += 3 * ng) {
            float v[3][8]; bf16_t* dst[3];
#pragma unroll
            for (int q = 0; q < 3; ++q) {
                const size_t i = i0_ + (size_t)q * ng; const bool ok = i < nI + nO + nQ; const size_t ii = ok ? i : gt;
                const float* W; bf16_t* WT; int N, pitch, n, kc, sc_;
                if (ii < nI) { N = NPROJ; pitch = INW; W = p.w_in; WT = WTI; n = (int)(ii % N); kc = (int)(ii / N); sc_ = n < 1536 ? n : n + 8; }
                else if (ii < nI + nO) { const size_t j = ii - nI; N = 1024; pitch = 1024; W = p.w_out; WT = WTO; n = (int)(j % N); kc = (int)(j / N); sc_ = n; }
                else { const size_t j = ii - nI - nO; N = 2048; pitch = 2048; W = p.w_query; WT = WTQ; n = (int)(j % N); kc = (int)(j / N); sc_ = n; }
#pragma unroll
                for (int j = 0; j < 8; ++j) v[q][j] = W[(size_t)(kc * 8 + j) * pitch + sc_];
                dst[q] = ok ? WT + (size_t)n * 1024 + kc * 8 : nullptr;
            }
#pragma unroll
            for (int q = 0; q < 3; ++q) if (dst[q]) { u32x4 w; w.x = cvtpk(v[q][0], v[q][1]); w.y = cvtpk(v[q][2], v[q][3]); w.z = cvtpk(v[q][4], v[q][5]); w.w = cvtpk(v[q][6], v[q][7]); *(u32x4*)dst[q] = w; }
        }
    }
    {
        float* WF = (float*)(p.ws + WS_WF);
        for (size_t i = gt; i < 8 * 1024; i += ng) { const int hd = (int)(i & 7), k = (int)(i >> 3); WF[hd * 1024 + k] = p.w_in[(size_t)k * INW + 1536 + hd]; }
    }
}

__device__ __forceinline__ void ld16(const float* rowp, int lane, float (&v)[16]) {
    const f32x4 a = *(const f32x4*)(rowp + 8 * lane), b = *(const f32x4*)(rowp + 8 * lane + 4), c = *(const f32x4*)(rowp + 512 + 8 * lane), d = *(const f32x4*)(rowp + 512 + 8 * lane + 4);
#pragma unroll
    for (int i = 0; i < 4; ++i) { v[i] = a[i]; v[4 + i] = b[i]; v[8 + i] = c[i]; v[12 + i] = d[i]; }
}
__device__ __forceinline__ void st16_bf16(bf16_t* rowp, int lane, const float (&v)[16]) {
    u32x4 w0, w1; w0.x = cvtpk(v[0], v[1]); w0.y = cvtpk(v[2], v[3]); w0.z = cvtpk(v[4], v[5]); w0.w = cvtpk(v[6], v[7]);
    w1.x = cvtpk(v[8], v[9]); w1.y = cvtpk(v[10], v[11]); w1.z = cvtpk(v[12], v[13]); w1.w = cvtpk(v[14], v[15]);
    *(u32x4*)(rowp + 8 * lane) = w0; *(u32x4*)(rowp + 512 + 8 * lane) = w1;
}
__device__ __forceinline__ void ld16_bf16(const bf16_t* rowp, int lane, float (&v)[16]) {
    const u32x4 w0 = *(const u32x4*)(rowp + 8 * lane), w1 = *(const u32x4*)(rowp + 512 + 8 * lane);
    v[0] = bflo(w0.x); v[1] = bfhi(w0.x); v[2] = bflo(w0.y); v[3] = bfhi(w0.y); v[4] = bflo(w0.z); v[5] = bfhi(w0.z); v[6] = bflo(w0.w); v[7] = bfhi(w0.w);
    v[8] = bflo(w1.x); v[9] = bfhi(w1.x); v[10] = bflo(w1.y); v[11] = bfhi(w1.y); v[12] = bflo(w1.z); v[13] = bfhi(w1.z); v[14] = bflo(w1.w); v[15] = bfhi(w1.w);
}
__device__ __forceinline__ void st16(float* rowp, int lane, const float (&v)[16]) {
    *(f32x4*)(rowp + 8 * lane) = (f32x4){v[0], v[1], v[2], v[3]}; *(f32x4*)(rowp + 8 * lane + 4) = (f32x4){v[4], v[5], v[6], v[7]};
    *(f32x4*)(rowp + 512 + 8 * lane) = (f32x4){v[8], v[9], v[10], v[11]}; *(f32x4*)(rowp + 512 + 8 * lane + 4) = (f32x4){v[12], v[13], v[14], v[15]};
}

#define DPP_ADDF(v, ctrl) v += __uint_as_float((unsigned)__builtin_amdgcn_update_dpp(0, (int)__float_as_uint(v), ctrl, 0xf, 0xf, true))
__device__ __forceinline__ float wave_sum_dpp(float v) {
    DPP_ADDF(v, 0xB1); DPP_ADDF(v, 0x4E); DPP_ADDF(v, 0x141); DPP_ADDF(v, 0x140);
    const float a = __uint_as_float((unsigned)__builtin_amdgcn_readlane((int)__float_as_uint(v), 0)), b = __uint_as_float((unsigned)__builtin_amdgcn_readlane((int)__float_as_uint(v), 16));
    const float c = __uint_as_float((unsigned)__builtin_amdgcn_readlane((int)__float_as_uint(v), 32)), d = __uint_as_float((unsigned)__builtin_amdgcn_readlane((int)__float_as_uint(v), 48));
    return (a + b) + (c + d);
}
__device__ __forceinline__ void phase1(const Params& p, LAS unsigned char* lds) {
    const int tid_ = fresh_tid(); const int lane = tid_ & 63, wid = tid_ >> 6;
    const int gw = blockIdx.x * NWAVES + wid, ngw = gridDim.x * NWAVES;
    const float* mod = (const float*)(p.ws + WS_MOD); const float* WF = (const float*)(p.ws + WS_WF);
    bf16_t* H = (bf16_t*)(p.ws + WS_H); float* LS = (float*)(p.ws + WS_LS);
    LAS float* wfl = (LAS float*)lds;
    for (int i = tid_; i < 8 * DM / 4; i += NTHREADS) *(LAS f32x4*)(wfl + 4 * i) = *(const f32x4*)(WF + 4 * i);
    __syncthreads();
    float g[16]; ld16(p.g_pre_mix, lane, g);
    const float bfg = (lane & 7) == 0 ? p.b_fgate[lane >> 3] : 0.f;
    for (int t0 = gw * 16; t0 < T; t0 += ngw * 16) {
        const int b = t0 / SEQ;
        float A[16], sh[16];
        { float sc[16]; ld16(mod + b * NMOD, lane, sh); ld16(mod + b * NMOD + DM, lane, sc);
#pragma unroll
          for (int i = 0; i < 16; ++i) A[i] = g[i] * (1.f + sc[i]); }
        float xn[16]; ld16(p.x + (size_t)t0 * DM, lane, xn);
#pragma unroll 1
        for (int r = 0; r < 16; ++r) {
            const int t = t0 + r;
            float xv[16];
#pragma unroll
            for (int i = 0; i < 16; ++i) xv[i] = xn[i];
            if (r + 1 < 16) ld16(p.x + (size_t)(t + 1) * DM, lane, xn);
            float ss = 0.f;
#pragma unroll
            for (int i = 0; i < 16; ++i) ss += xv[i] * xv[i];
            const float rstd = rsqrtf(wave_sum_dpp(ss) * (1.f / DM) + RMS_EPS);
            float h[16];
#pragma unroll
            for (int i = 0; i < 16; ++i) h[i] = xv[i] * rstd * A[i] + sh[i];
            st16_bf16(H + (size_t)t * DM, lane, h);
            float s[8];
#pragma unroll
            for (int hd = 0; hd < 8; ++hd) {
                const LAS float* wr = wfl + hd * DM;
                const f32x4 w0 = *(const LAS f32x4*)(wr + 8 * lane), w1 = *(const LAS f32x4*)(wr + 8 * lane + 4), w2 = *(const LAS f32x4*)(wr + 512 + 8 * lane), w3 = *(const LAS f32x4*)(wr + 512 + 8 * lane + 4);
                float a = 0.f;
#pragma unroll
                for (int i = 0; i < 4; ++i) a += h[i] * w0[i] + h[4 + i] * w1[i] + h[8 + i] * w2[i] + h[12 + i] * w3[i];
                s[hd] = a;
            }
            const bool b32 = (lane & 32) != 0, b16 = (lane & 16) != 0, b8 = (lane & 8) != 0;
            float r4[4], r2[2], v;
#pragma unroll
            for (int k = 0; k < 4; ++k) { const float mine = b32 ? s[k + 4] : s[k], send = b32 ? s[k] : s[k + 4]; r4[k] = mine + __shfl_xor(send, 32); }
#pragma unroll
            for (int k = 0; k < 2; ++k) { const float mine = b16 ? r4[k + 2] : r4[k], send = b16 ? r4[k] : r4[k + 2]; r2[k] = mine + __shfl_xor(send, 16); }
            { const float mine = b8 ? r2[1] : r2[0], send = b8 ? r2[0] : r2[1]; v = mine + __shfl_xor(send, 8); }
            v += __shfl_xor(v, 4); v += __shfl_xor(v, 2); v += __shfl_xor(v, 1);
            if ((lane & 7) == 0) { const float z = v + bfg;
                const float lsg = z >= 0.f ? -log1pf(__expf(-z)) : z - log1pf(__expf(z));
                LS[(size_t)t * 8 + (lane >> 3)] = lsg; }
        }
    }
    __syncthreads();
}

__device__ __forceinline__ void scan_kb(const Params& p, LAS unsigned char* lds) {
    const int first = (int)gridDim.x >= BATCH * 8 ? (int)gridDim.x - BATCH * 8 : 0;
    for (int sb = (int)blockIdx.x - first; sb >= 0 && sb < BATCH * 8; sb += (int)gridDim.x) {
        const int tid = fresh_tid(), lane = tid & 63, wid = tid >> 6, b = sb >> 3, hd = sb & 7;
        const float* LS = (const float*)(p.ws + WS_LS) + (size_t)b * SEQ * 8 + hd; float* KB = (float*)(p.ws + WS_KB) + (size_t)sb * SEQ;
        LAS double* wtot = (LAS double*)lds;
        double loc[16]; double s = 0.0;
#pragma unroll
        for (int i = 0; i < 16; ++i) { s += (double)LS[(size_t)(tid * 16 + i) * 8]; loc[i] = s; }
        double v = s;
#pragma unroll
        for (int o = 1; o < 64; o <<= 1) { const double u = __shfl_up(v, o); if (lane >= o) v += u; }
        __syncthreads();
        if (lane == 63) wtot[wid] = v;
        __syncthreads();
        double base = v - s;
        for (int w = 0; w < wid; ++w) base += wtot[w];
#pragma unroll
        for (int i = 0; i < 16; ++i) KB[tid * 16 + i] = (float)(-(base + loc[i]) * (double)LOG2E);
        __syncthreads();
    }
}

__device__ __forceinline__ void stage_kv_tile(LAS unsigned char* kimg, LAS unsigned char* vimg, const bf16_t* Kg, const bf16_t* Vg, long row0, long rowmin, int pitch, int wid, int lane) {
    long rk = row0 + lane; if (rk < rowmin) rk = rowmin;
    const bf16_t* ks = Kg + rk * pitch + wid * 8;
    __builtin_amdgcn_global_load_lds((const unsigned*)ks, (LAS unsigned*)(kimg + wid * 1024), 16, 0, 0);
    long rv = row0 + 16 * (wid & 3) + (lane >> 2); if (rv < rowmin) rv = rowmin;
    const bf16_t* vs = Vg + rv * pitch + (wid >> 2) * 32 + (lane & 3) * 8;
    __builtin_amdgcn_global_load_lds((const unsigned*)vs, (LAS unsigned*)(vimg + wid * 1024), 16, 0, 0);
}
__device__ __forceinline__ s16x4 vtr(const LAS unsigned char* ptr) {
    typedef short v4i16_t __attribute__((ext_vector_type(4)));
    return __builtin_bit_cast(s16x4, __builtin_amdgcn_ds_read_tr16_b64_v4i16((LAS v4i16_t*)ptr));
}
__device__ __forceinline__ void qk_tile(f32x16& p0, f32x16& p1, const LAS unsigned char* kimg, const bf16x8 (&qr)[4], int r32, int hi) {
    const LAS unsigned char* kb = kimg + hi * 1024 + r32 * 16;
    p0 = (f32x16){}; p1 = (f32x16){};
#pragma unroll
    for (int d0 = 0; d0 < 4; ++d0) {
        const bf16x8 b0 = *(const LAS bf16x8*)(kb + d0 * 2048), b1 = *(const LAS bf16x8*)(kb + d0 * 2048 + 512);
        p0 = __builtin_amdgcn_mfma_f32_32x32x16_bf16(b0, qr[d0], p0, 0, 0, 0);
        p1 = __builtin_amdgcn_mfma_f32_32x32x16_bf16(b1, qr[d0], p1, 0, 0, 0);
    }
}
__device__ __forceinline__ void softmax_pv(f32x16& p0, f32x16& p1, const LAS unsigned char* vimg, f32x16& o0, f32x16& o1, float& m, float& l, int lane, int hi) {
    float rm = p0[0];
#pragma unroll
    for (int r = 1; r < 16; ++r) rm = fmaxf(rm, p0[r]);
#pragma unroll
    for (int r = 0; r < 16; ++r) rm = fmaxf(rm, p1[r]);
    rm = fmaxf(rm, __shfl_xor(rm, 32));
    const float mn = fmaxf(m, rm);
    const float alpha = __builtin_amdgcn_exp2f(m - mn);
    m = mn;
    float ps = 0.f;
#pragma unroll
    for (int r = 0; r < 16; ++r) { p0[r] = __builtin_amdgcn_exp2f(p0[r] - mn); ps += p0[r]; }
#pragma unroll
    for (int r = 0; r < 16; ++r) { p1[r] = __builtin_amdgcn_exp2f(p1[r] - mn); ps += p1[r]; }
    l = l * alpha + ps;
    if (!__all(alpha == 1.0f)) {
#pragma unroll
        for (int r = 0; r < 16; ++r) { const float a = __shfl(alpha, crow(r, hi)); o0[r] *= a; o1[r] *= a; }
    }
    u32x4 pw[4];
    pw[0] = (u32x4){cvtpk(p0[0], p0[1]), cvtpk(p0[2], p0[3]), cvtpk(p0[4], p0[5]), cvtpk(p0[6], p0[7])};
    pw[1] = (u32x4){cvtpk(p0[8], p0[9]), cvtpk(p0[10], p0[11]), cvtpk(p0[12], p0[13]), cvtpk(p0[14], p0[15])};
    pw[2] = (u32x4){cvtpk(p1[0], p1[1]), cvtpk(p1[2], p1[3]), cvtpk(p1[4], p1[5]), cvtpk(p1[6], p1[7])};
    pw[3] = (u32x4){cvtpk(p1[8], p1[9]), cvtpk(p1[10], p1[11]), cvtpk(p1[12], p1[13]), cvtpk(p1[14], p1[15])};
    const LAS unsigned char* vb = vimg + ((lane >> 4) & 1) * 32 + (lane & 3) * 8 + (4 * hi + ((lane & 15) >> 2)) * 64;
#pragma unroll
    for (int ks = 0; ks < 4; ++ks) {
        const bf16x8 pa = __builtin_bit_cast(bf16x8, pw[ks]);
        { const s16x4 lo = vtr(vb + ks * 1024), hh = vtr(vb + ks * 1024 + 512);
          const bf16x8 vf = (bf16x8){lo[0], lo[1], lo[2], lo[3], hh[0], hh[1], hh[2], hh[3]};
          o0 = __builtin_amdgcn_mfma_f32_32x32x16_bf16(pa, vf, o0, 0, 0, 0); }
        { const s16x4 lo = vtr(vb + 4096 + ks * 1024), hh = vtr(vb + 4096 + ks * 1024 + 512);
          const bf16x8 vf = (bf16x8){lo[0], lo[1], lo[2], lo[3], hh[0], hh[1], hh[2], hh[3]};
          o1 = __builtin_amdgcn_mfma_f32_32x32x16_bf16(pa, vf, o1, 0, 0, 0); }
    }
}
__device__ __forceinline__ void store_o(bf16_t* Obase  , int pitch, const f32x16& o0, const f32x16& o1, float linv, int r32, int hi) {
#pragma unroll
    for (int r = 0; r < 16; ++r) { const int q = crow(r, hi); const float li = __shfl(linv, q);
        bf16_t* rp = Obase + (size_t)q * pitch;
        rp[r32] = (bf16_t)(cvtpk(o0[r] * li, 0.f) & 0xffffu); rp[32 + r32] = (bf16_t)(cvtpk(o1[r] * li, 0.f) & 0xffffu); }
}

constexpr float FOX_THR = 30.f;
__device__ __forceinline__ void glds16(const void* gsrc, unsigned lds_dst) {
    unsigned keep;
    asm volatile("s_mov_b32 %0, m0\n\ts_mov_b32 m0, %2\n\ts_nop 0\n\tglobal_load_lds_dwordx4 %1, off\n\ts_mov_b32 m0, %0" : "=&s"(keep) : "v"(gsrc), "s"(lds_dst) : "memory");
}
__device__ __forceinline__ unsigned f2ord(float f) { const unsigned b = __float_as_uint(f); return (b & 0x80000000u) ? ~b : (b | 0x80000000u); }
__device__ __forceinline__ float ord2f(unsigned u) { return __uint_as_float((u & 0x80000000u) ? (u & 0x7fffffffu) : ~u); }
__device__ __forceinline__ void fox_prepass(const Params& p) {
    const int tid = fresh_tid(), lane = tid & 63, gw = blockIdx.x * NWAVES + (tid >> 6), ngw = gridDim.x * NWAVES;
    const bf16_t* PROJ = (const bf16_t*)(p.ws + WS_PROJ); float* KT = (float*)(p.ws + WS_KT);
    for (int it = gw; it < 32 * 128; it += ngw) {
        const int bh = it >> 7, j = it & 127, b = bh >> 3, h = bh & 7;
        const bf16_t* kr = PROJ + (size_t)((long)b * SEQ + 64 * j + lane) * NPROJ + 512 + h * 64;
        float ss = 0.f;
#pragma unroll
        for (int c = 0; c < 8; ++c) { const u32x4 w = *(const u32x4*)(kr + 8 * c);
            ss += bflo(w.x) * bflo(w.x) + bfhi(w.x) * bfhi(w.x) + bflo(w.y) * bflo(w.y) + bfhi(w.y) * bfhi(w.y) + bflo(w.z) * bflo(w.z) + bfhi(w.z) * bfhi(w.z) + bflo(w.w) * bflo(w.w) + bfhi(w.w) * bfhi(w.w); }
#pragma unroll
        for (int o = 1; o < 64; o <<= 1) ss = fmaxf(ss, __shfl_xor(ss, o));
        if (lane == 0) KT[it] = ss;
    }
}
constexpr int FOX_BUF = 16384, FOX_NBUF = 4, FOX_KB_OFF = FOX_NBUF * FOX_BUF, FOX_CTL_OFF = FOX_KB_OFF + 32768;
#define FOX_WAIT_BAR(N) asm volatile("s_waitcnt vmcnt(" #N ")\n\ts_barrier" ::: "memory")
__device__ __forceinline__ void fox_stage(unsigned ldsbase, int slot, const bf16_t* Kg, const bf16_t* Vg, long row0, int wid, int lane) {
    const bf16_t* ks = Kg + (row0 + lane) * NPROJ + wid * 8;
    const bf16_t* vs = Vg + (row0 + 16 * (wid & 3) + (lane >> 2)) * NPROJ + (wid >> 2) * 32 + (lane & 3) * 8;
    const unsigned dst = (unsigned)__builtin_amdgcn_readfirstlane((int)(ldsbase + (unsigned)slot * FOX_BUF + (unsigned)wid * 1024u));
    glds16(ks, dst); glds16(vs, dst + 8192u);
}
__device__ __forceinline__ void fox_unit(const Params& p, LAS unsigned char* lds, int b, int h, int qb) {
    const int tid = fresh_tid(), lane = tid & 63, wid = __builtin_amdgcn_readfirstlane(tid >> 6), r32 = lane & 31, hi = lane >> 5;
    const bf16_t* PROJ = (const bf16_t*)(p.ws + WS_PROJ);
    bf16_t* ATT = (bf16_t*)(p.ws + WS_ATT);
    const float* KB = (const float*)(p.ws + WS_KB) + (size_t)(b * 8 + h) * SEQ;
    const float* KT = (const float*)(p.ws + WS_KT) + (b * 8 + h) * 128;
    const long rowb = (long)b * SEQ; const int q0 = qb * 256;
    const bf16_t* Kg = PROJ + 512 + h * 64; const bf16_t* Vg = PROJ + 1024 + h * 64;
    LAS float* kbl = (LAS float*)(lds + FOX_KB_OFF); LAS unsigned* ctl = (LAS unsigned*)(lds + FOX_CTL_OFF);
    const unsigned ldsbase = (unsigned)(uintptr_t)lds;
    const int qw = q0 + 32 * wid;
    const int NT = (q0 + 256) / 64;
    bf16x8 qr[4]; float qn2 = 0.f, xs = 0.f;
#pragma unroll
    for (int d0 = 0; d0 < 4; ++d0) {
        qr[d0] = *(const bf16x8*)(PROJ + (size_t)(rowb + qw + r32) * NPROJ + h * 64 + d0 * 16 + hi * 8);
        const bf16x8 kk = *(const bf16x8*)(PROJ + (size_t)(rowb + qw + r32) * NPROJ + 512 + h * 64 + d0 * 16 + hi * 8);
#pragma unroll
        for (int j = 0; j < 8; ++j) { const float v = __uint_as_float(((unsigned)(unsigned short)qr[d0][j]) << 16), kv = __uint_as_float(((unsigned)(unsigned short)kk[j]) << 16); qn2 += v * v; xs += v * kv; }
    }
    qn2 += __shfl_xor(qn2, 32); xs += __shfl_xor(xs, 32);
    const float kbq = KB[qw + r32];
    float kt_ = 0.f, kbe_ = 0.f;
    if (tid < NT) { kt_ = KT[tid]; kbe_ = KB[64 * tid + 63]; }
    __syncthreads();
    if (tid == 0) { ctl[0] = 0u; ctl[1] = (unsigned)(NT - 4); ctl[2] = 0u; ctl[3] = 0xffffffffu; }
    __syncthreads();
    { float qm = qn2, sm = xs + kbq;
#pragma unroll
      for (int o = 1; o < 32; o <<= 1) { qm = fmaxf(qm, __shfl_xor(qm, o)); sm = fminf(sm, __shfl_xor(sm, o)); }
      if (lane == 0) { atomicMax((unsigned*)&ctl[0], __float_as_uint(qm)); atomicMin((unsigned*)&ctl[3], f2ord(sm)); } }
    __syncthreads();
    const float qmax2 = __uint_as_float(ctl[0]);
    if (tid < NT - 4) {
        const float smin = ord2f(ctl[3]);
        const float ub = sqrtf(qmax2 * kt_) * 1.0001f + kbe_;
        if (!(ub + FOX_THR <= smin - 1e-3f * fabsf(smin))) atomicMin((unsigned*)&ctl[1], (unsigned)tid);
    }
    __syncthreads();
    const int jstart = (int)ctl[1];
    __builtin_amdgcn_s_waitcnt(0);
    fox_stage(ldsbase, 0, Kg, Vg, rowb + 64 * jstart, wid, lane);
    if (jstart + 1 < NT) fox_stage(ldsbase, 1, Kg, Vg, rowb + 64 * (jstart + 1), wid, lane);
    if (jstart + 2 < NT) fox_stage(ldsbase, 2, Kg, Vg, rowb + 64 * (jstart + 2), wid, lane);
    if (tid >= jstart && tid < NT) atomicMax((unsigned*)&ctl[2], __float_as_uint(kt_));
    for (int i = 64 * jstart + tid; i < 64 * NT; i += NTHREADS) kbl[i - 64 * jstart] = KB[i];
    __syncthreads();
    const float kmaxu = sqrtf(__uint_as_float(ctl[2]));
    const float ref = sqrtf(qn2) * kmaxu * 1.0001f + kbq;
    f32x16 o0 = (f32x16){}, o1 = (f32x16){}; float l = 0.f;
    for (int jt = jstart; jt < NT; ++jt) {
        if (jt + 2 < NT) FOX_WAIT_BAR(4); else if (jt + 1 < NT) FOX_WAIT_BAR(2); else FOX_WAIT_BAR(0);
        if (jt + 3 < NT) fox_stage(ldsbase, (jt + 3 - jstart) & 3, Kg, Vg, rowb + 64 * (jt + 3), wid, lane);
        LAS unsigned char* buf = lds + ((jt - jstart) & 3) * FOX_BUF;
        if (64 * jt <= qw + 31) {
            const LAS float* kbt = kbl + 64 * (jt - jstart);
            f32x16 p0, p1;
#pragma unroll
            for (int g = 0; g < 4; ++g) {
                const f32x4 k0 = *(const LAS f32x4*)(kbt + 8 * g + 4 * hi), k1 = *(const LAS f32x4*)(kbt + 32 + 8 * g + 4 * hi);
#pragma unroll
                for (int i = 0; i < 4; ++i) { p0[4 * g + i] = k0[i] - ref; p1[4 * g + i] = k1[i] - ref; }
            }
            { const LAS unsigned char* kb_ = buf + hi * 1024 + r32 * 16;
#pragma unroll
              for (int d0 = 0; d0 < 4; ++d0) {
                  const bf16x8 b0 = *(const LAS bf16x8*)(kb_ + d0 * 2048), b1 = *(const LAS bf16x8*)(kb_ + d0 * 2048 + 512);
                  p0 = __builtin_amdgcn_mfma_f32_32x32x16_bf16(b0, qr[d0], p0, 0, 0, 0);
                  p1 = __builtin_amdgcn_mfma_f32_32x32x16_bf16(b1, qr[d0], p1, 0, 0, 0);
              } }
            float ps = 0.f;
            if (64 * jt + 63 > qw) {
                const int tq = qw + r32;
#pragma unroll
                for (int r = 0; r < 16; ++r) { const int s_ = 64 * jt + crow(r, hi);
                    p0[r] = (s_ > tq) ? 0.f : __builtin_amdgcn_exp2f(p0[r]); p1[r] = (s_ + 32 > tq) ? 0.f : __builtin_amdgcn_exp2f(p1[r]); ps += p0[r] + p1[r]; }
            } else {
#pragma unroll
                for (int r = 0; r < 16; ++r) { p0[r] = __builtin_amdgcn_exp2f(p0[r]); p1[r] = __builtin_amdgcn_exp2f(p1[r]); ps += p0[r] + p1[r]; }
            }
            l += ps;
            u32x4 pw[4];
            pw[0] = (u32x4){cvtpk(p0[0], p0[1]), cvtpk(p0[2], p0[3]), cvtpk(p0[4], p0[5]), cvtpk(p0[6], p0[7])};
            pw[1] = (u32x4){cvtpk(p0[8], p0[9]), cvtpk(p0[10], p0[11]), cvtpk(p0[12], p0[13]), cvtpk(p0[14], p0[15])};
            pw[2] = (u32x4){cvtpk(p1[0], p1[1]), cvtpk(p1[2], p1[3]), cvtpk(p1[4], p1[5]), cvtpk(p1[6], p1[7])};
            pw[3] = (u32x4){cvtpk(p1[8], p1[9]), cvtpk(p1[10], p1[11]), cvtpk(p1[12], p1[13]), cvtpk(p1[14], p1[15])};
            const LAS unsigned char* vb = buf + 8192 + ((lane >> 4) & 1) * 32 + (lane & 3) * 8 + (4 * hi + ((lane & 15) >> 2)) * 64;
#pragma unroll
            for (int ks = 0; ks < 4; ++ks) {
                const bf16x8 pa = __builtin_bit_cast(bf16x8, pw[ks]);
                { const s16x4 lo = vtr(vb + ks * 1024), hh = vtr(vb + ks * 1024 + 512);
                  const bf16x8 vf = (bf16x8){lo[0], lo[1], lo[2], lo[3], hh[0], hh[1], hh[2], hh[3]};
                  o0 = __builtin_amdgcn_mfma_f32_32x32x16_bf16(pa, vf, o0, 0, 0, 0); }
                { const s16x4 lo = vtr(vb + 4096 + ks * 1024), hh = vtr(vb + 4096 + ks * 1024 + 512);
                  const bf16x8 vf = (bf16x8){lo[0], lo[1], lo[2], lo[3], hh[0], hh[1], hh[2], hh[3]};
                  o1 = __builtin_amdgcn_mfma_f32_32x32x16_bf16(pa, vf, o1, 0, 0, 0); }
            }
        }
    }
    const float lt = l + __shfl_xor(l, 32);
    const float linv = 1.f / lt;
    __syncthreads();
    {
        LAS bf16_t* stg = (LAS bf16_t*)(lds + wid * 4096);
#pragma unroll
        for (int r = 0; r < 16; ++r) { const int q = crow(r, hi); const float li = __shfl(linv, q);
            stg[q * 64 + r32] = (bf16_t)(cvtpk(o0[r] * li, 0.f) & 0xffffu); stg[q * 64 + 32 + r32] = (bf16_t)(cvtpk(o1[r] * li, 0.f) & 0xffffu); }
        bf16_t* Ow = ATT + (size_t)(rowb + qw) * DM + h * 64;
#pragma unroll
        for (int i = 0; i < 4; ++i) { const int row = i * 8 + (lane >> 3), ch = lane & 7; const u32x4 v = *(const LAS u32x4*)(stg + row * 64 + ch * 8); *(u32x4*)(Ow + (size_t)row * DM + ch * 8) = v; }
    }
}
__device__ __forceinline__ void phase_fox(const Params& p, LAS unsigned char* lds) {
    if ((gridDim.x & 7) == 0) {
        unsigned* qw_ = (unsigned*)(p.ws + WS_BAR) + 16 * (blockIdx.x & 7);
        LAS int* uq = (LAS int*)(lds + FOX_CTL_OFF + 64);
        const int x = blockIdx.x & 7;
        for (;;) {
            __syncthreads();
            if (threadIdx.x == 0) *uq = (int)atomicAdd(qw_, 1u);
            __syncthreads();
            const int u = *uq;
            if (u >= 128) break;
            const int i = u & 3;
            fox_unit(p, lds, i, (x - i) & 7, 31 - (u >> 2));
        }
    } else {
        for (int u = blockIdx.x; u < 1024; u += gridDim.x) fox_unit(p, lds, (u & 31) >> 3, u & 7, 31 - (u >> 5));
    }
}

__device__ __forceinline__ void swa_unit(const Params& p, LAS unsigned char* lds, int b, int kvh, int qblk) {
    const int tid = fresh_tid(), lane = tid & 63, wid = __builtin_amdgcn_readfirstlane(tid >> 6), r32 = lane & 31, hi = lane >> 5;
    const bf16_t* PROJ = (const bf16_t*)(p.ws + WS_PROJ);
    bf16_t* ATT = (bf16_t*)(p.ws + WS_ATT);
    const long rowb = (long)b * SEQ; const int q0 = qblk * 128;
    const bf16_t* Kg = PROJ + 2048 + kvh * 64; const bf16_t* Vg = PROJ + 2176 + kvh * 64;
    __syncthreads();
#pragma unroll
    for (int j = 0; j < 4; ++j) stage_kv_tile(lds + j * 16384, lds + j * 16384 + 8192, Kg, Vg, rowb + q0 - 128 + 64 * j, rowb, NPROJ, wid, lane);
    __syncthreads();
#pragma unroll 1
    for (int i = 0; i < 2; ++i) {
        const int task = wid * 2 + i, g = task >> 2, sub = task & 3, hq = kvh * 4 + g;
        const int qw = q0 + 32 * sub;
        const float slope = exp2f(-(float)(hq + 1)) * LOG2E;
        bf16x8 qr[4];
#pragma unroll
        for (int d0 = 0; d0 < 4; ++d0) qr[d0] = *(const bf16x8*)(PROJ + (size_t)(rowb + qw + r32) * NPROJ + 1536 + hq * 64 + d0 * 16 + hi * 8);
        f32x16 o0 = (f32x16){}, o1 = (f32x16){}; float m = NEGBIG, l = 0.f;
        const int j0 = (32 * sub + 1) >> 6, j1 = (32 * sub + 159) >> 6;
        for (int j = j0; j <= j1; ++j) {
            f32x16 p0, p1; qk_tile(p0, p1, lds + j * 16384, qr, r32, hi);
            const int tq = 128 + 32 * sub + r32;
#pragma unroll
            for (int r = 0; r < 16; ++r) {
                const int s0 = 64 * j + crow(r, hi), s1 = s0 + 32;
                const int d0 = tq - s0, d1 = tq - s1;
                const bool v0 = (d0 >= 0) && (d0 < 128) && (q0 - 128 + s0 >= 0), v1 = (d1 >= 0) && (d1 < 128) && (q0 - 128 + s1 >= 0);
                p0[r] = v0 ? p0[r] - slope * (float)d0 : NEGBIG; p1[r] = v1 ? p1[r] - slope * (float)d1 : NEGBIG;
            }
            softmax_pv(p0, p1, lds + j * 16384 + 8192, o0, o1, m, l, lane, hi);
        }
        float lt = l + __shfl_xor(l, 32);
        lt += exp2f(p.swa_sinks[hq] * LOG2E - m);
        store_o(ATT + (size_t)(rowb + qw) * DM + 512 + hq * 64, DM, o0, o1, 1.f / lt, r32, hi);
    }
}
__device__ __forceinline__ void phase_swa(const Params& p, LAS unsigned char* lds) {
    for (int u = blockIdx.x; u < BATCH * 2 * 64; u += gridDim.x) { const int bk = u & 7; swa_unit(p, lds, bk >> 1, bk & 1, u >> 3); }
}

__device__ __forceinline__ void phase6(const Params& p) {
    const int tid_ = fresh_tid(); const int lane = tid_ & 63, wid = tid_ >> 6;
    const int gw = blockIdx.x * NWAVES + wid, ngw = gridDim.x * NWAVES;
    const float* mod = (const float*)(p.ws + WS_MOD);
    const bf16_t* Y1 = (const bf16_t*)(p.ws + WS_PROJ); bf16_t* H = (bf16_t*)(p.ws + WS_H);
    float* X1 = (float*)(p.ws + WS_X1); float* HMAX = (float*)(p.ws + WS_HMAX);
    float gpm[16], gpf[16]; ld16(p.g_post_mix, lane, gpm); ld16(p.g_pre_ffn, lane, gpf);
    for (int t0 = gw * 16; t0 < T; t0 += ngw * 16) {
        const int b = t0 / SEQ;
        float G1[16], A2[16], sh[16];
        { float gt[16], sc[16]; ld16(mod + b * NMOD + 2 * DM, lane, gt); ld16(mod + b * NMOD + 3 * DM, lane, sh); ld16(mod + b * NMOD + 4 * DM, lane, sc);
#pragma unroll
          for (int i = 0; i < 16; ++i) { G1[i] = gt[i] * gpm[i]; A2[i] = gpf[i] * (1.f + sc[i]); } }
        float yn[16], xn[16]; ld16_bf16(Y1 + (size_t)t0 * DM, lane, yn); ld16(p.x + (size_t)t0 * DM, lane, xn);
#pragma unroll 1
        for (int r = 0; r < 16; ++r) {
            const int t = t0 + r;
            float y[16], xv[16];
#pragma unroll
            for (int i = 0; i < 16; ++i) { y[i] = yn[i]; xv[i] = xn[i]; }
            if (r + 1 < 16) { ld16_bf16(Y1 + (size_t)(t + 1) * DM, lane, yn); ld16(p.x + (size_t)(t + 1) * DM, lane, xn); }
            float ss = 0.f;
#pragma unroll
            for (int i = 0; i < 16; ++i) ss += y[i] * y[i];
            const float rstd = rsqrtf(wave_sum_dpp(ss) * (1.f / DM) + RMS_EPS);
            float x1[16]; float s2 = 0.f;
#pragma unroll
            for (int i = 0; i < 16; ++i) { x1[i] = xv[i] + G1[i] * (y[i] * rstd); s2 += x1[i] * x1[i]; }
            st16_bf16((bf16_t*)(p.ws + WS_X1) + (size_t)t * DM, lane, x1);
            const float rstd2 = rsqrtf(wave_sum_dpp(s2) * (1.f / DM) + RMS_EPS);
            float h[16]; float hm = 0.f;
#pragma unroll
            for (int i = 0; i < 16; ++i) { h[i] = x1[i] * rstd2 * A2[i] + sh[i]; hm = fmaxf(hm, fabsf(__uint_as_float(cvtpk(h[i], 0.f) << 16))); }
            st16_bf16(H + (size_t)t * DM, lane, h);
#pragma unroll
            for (int o = 1; o < 64; o <<= 1) hm = fmaxf(hm, __shfl_xor(hm, o));
            if (lane == 0) HMAX[t] = hm;
        }
    }
}

template <int N> __device__ __forceinline__ void bitonic_sort_desc(float (&v)[N]) {
#pragma unroll
    for (int k = 2; k <= N; k <<= 1)
#pragma unroll
        for (int j = k >> 1; j > 0; j >>= 1)
#pragma unroll
            for (int i = 0; i < N; ++i) { const int x = i ^ j; if (x > i) { const bool up = ((i & k) == 0); const float a = v[i], b = v[x]; const float mx = vmaxf(a, b), mn = vminf(a, b); v[i] = up ? mx : mn; v[x] = up ? mn : mx; } }
}
__device__ __forceinline__ void bitonic_merge16_desc(float (&v)[16]) {
#pragma unroll
    for (int j = 8; j > 0; j >>= 1)
#pragma unroll
        for (int i = 0; i < 16; ++i) { const int x = i ^ j; if (x > i) { const float a = v[i], b = v[x]; v[i] = vmaxf(a, b); v[x] = vminf(a, b); } }
}
__device__ __forceinline__ void merge_partner(float (&a)[16], int xm) {
    float c[16];
#pragma unroll
    for (int i = 0; i < 16; ++i) c[i] = vmaxf(a[i], __shfl_xor(a[15 - i], xm));
    bitonic_merge16_desc(c);
#pragma unroll
    for (int i = 0; i < 16; ++i) a[i] = c[i];
}
__device__ __forceinline__ unsigned sel4(unsigned w0, unsigned w1, unsigned w2, unsigned w3, unsigned a) {
    const unsigned lo = (a & 4u) ? w1 : w0, hi2 = (a & 4u) ? w3 : w2; const unsigned w = (a & 8u) ? hi2 : lo; return (w >> (8u * (a & 3u))) & 0x7fu;
}
__device__ __forceinline__ void p8_stage(LAS unsigned char* buf, const bf16_t* SK, int g, int wid, int lane) {
#pragma unroll
    for (int j = 0; j < 4; ++j) { const int pc = wid * 4 + j, row = 4 * pc + (lane >> 4), pos = lane & 15;
        const unsigned char* src = (const unsigned char*)SK + (size_t)g * 32768 + row * 256 + ((pos ^ (row & 15)) << 4);
        __builtin_amdgcn_global_load_lds((const unsigned*)src, (LAS unsigned*)(buf + pc * 1024), 16, 0, 0); }
}
__device__ __forceinline__ void phase8_block(const Params& p, LAS unsigned char* lds, int t0, int wid, int lane) {
    const int fr = lane & 15, fq = lane >> 4;
    const bf16_t* Q2 = (const bf16_t*)(p.ws + WS_PROJ); const bf16_t* SK = (const bf16_t*)(p.ws + WS_SK);
    int* EIDX = (int*)(p.ws + WS_EIDX); float* GATE = (float*)(p.ws + WS_GATE);
    float keep[2][2][16];
#pragma unroll
    for (int a_ = 0; a_ < 2; ++a_)
#pragma unroll
        for (int b_ = 0; b_ < 2; ++b_)
#pragma unroll
            for (int i_ = 0; i_ < 16; ++i_) keep[a_][b_][i_] = 0.f;
    const bf16_t* qrow = Q2 + (size_t)(t0 + fr) * 2048 + 8 * fq;
    bf16x8 bqn[4];
#pragma unroll
    for (int s = 0; s < 4; ++s) bqn[s] = *(const bf16x8*)(qrow + 32 * s);
    __syncthreads();
    p8_stage(lds, SK, 0, wid, lane);
#pragma unroll 1
    for (int hp = 0; hp < 4; ++hp) {
#pragma unroll
        for (int hh = 0; hh < 2; ++hh) {
#pragma unroll
            for (int pp = 0; pp < 2; ++pp) {
                const int grp = (2 * hp + hh) * 2 + pp;
                bf16x8 bq[4];
#pragma unroll
                for (int s = 0; s < 4; ++s) bq[s] = bqn[s];
                __syncthreads();
                if (grp + 1 < 16) { p8_stage(lds + ((grp + 1) & 1) * 32768, SK, grp + 1, wid, lane);
#pragma unroll
                    for (int s = 0; s < 4; ++s) bqn[s] = *(const bf16x8*)(qrow + (grp + 1) * 128 + 32 * s); }
                const LAS unsigned char* kb_ = lds + (grp & 1) * 32768 + fr * 256;
                float v[32];
#pragma unroll
                for (int mt = 0; mt < 8; ++mt) {
                    f32x4 acc = (f32x4){0.f, 0.f, 0.f, 0.f};
#pragma unroll
                    for (int s = 0; s < 4; ++s) { const bf16x8 a = *(const LAS bf16x8*)(kb_ + mt * 4096 + (((4 * s + fq) ^ fr) << 4)); acc = __builtin_amdgcn_mfma_f32_16x16x32_bf16(a, bq[s], acc, 0, 0, 0); }
                    unsigned f4 = 4u * (unsigned)fq; asm volatile("" : "+v"(f4));
#pragma unroll
                    for (int i = 0; i < 4; ++i) v[mt * 4 + i] = __uint_as_float(((__float_as_uint(acc[i]) & ~127u) | f4) | (unsigned)(16 * mt + i));
                }
                bitonic_sort_desc<32>(v);
                float a16[16];
#pragma unroll
                for (int i = 0; i < 16; ++i) a16[i] = v[i];
                merge_partner(a16, 16); merge_partner(a16, 32);
                const bool mine = (fq == hp);
#pragma unroll
                for (int i = 0; i < 16; ++i) keep[hh][pp][i] = mine ? a16[i] : keep[hh][pp][i];
            }
        }
    }
#pragma unroll
    for (int hh = 0; hh < 2; ++hh) {
        const float (&L1)[16] = keep[hh][0]; const float (&L2)[16] = keep[hh][1];
#define P8_CAND(a, b) __uint_as_float((__float_as_uint(L1[a] + L2[b]) & ~255u) | (unsigned)((a) * 16 + (b)))
        float R[16], Bl[16], Cl[16];
#pragma unroll
        for (int bb = 0; bb < 16; ++bb) R[bb] = P8_CAND(0, bb);
#pragma unroll
        for (int i = 0; i < 8; ++i) { Bl[i] = P8_CAND(1, i); Bl[8 + i] = P8_CAND(15 - i, 0); }
        bitonic_merge16_desc(Bl);
        Cl[0] = P8_CAND(2, 0); Cl[1] = P8_CAND(2, 1); Cl[2] = P8_CAND(2, 2); Cl[3] = P8_CAND(2, 3); Cl[4] = P8_CAND(2, 4);
        Cl[5] = P8_CAND(3, 0); Cl[6] = P8_CAND(3, 1); Cl[7] = P8_CAND(3, 2); Cl[8] = P8_CAND(3, 3);
        Cl[9] = P8_CAND(4, 0); Cl[10] = P8_CAND(4, 1); Cl[11] = P8_CAND(4, 2);
        Cl[12] = P8_CAND(5, 0); Cl[13] = P8_CAND(5, 1); Cl[14] = P8_CAND(6, 0); Cl[15] = P8_CAND(6, 1);
        bitonic_sort_desc<16>(Cl);
        { float c[16];
#pragma unroll
          for (int i = 0; i < 16; ++i) c[i] = vmaxf(R[i], Bl[15 - i]);
          bitonic_merge16_desc(c);
#pragma unroll
          for (int i = 0; i < 16; ++i) c[i] = vmaxf(c[i], Cl[15 - i]);
          bitonic_merge16_desc(c);
          c[15] = vmaxf(c[15], P8_CAND(7, 0)); c[14] = vmaxf(c[14], P8_CAND(7, 1));
          bitonic_merge16_desc(c);
#pragma unroll
          for (int i = 0; i < 16; ++i) R[i] = c[i]; }
#undef P8_CAND
        unsigned pk1[4], pk2[4];
#pragma unroll
        for (int w = 0; w < 4; ++w) {
            pk1[w] = (__float_as_uint(L1[4 * w]) & 127u) | ((__float_as_uint(L1[4 * w + 1]) & 127u) << 8) | ((__float_as_uint(L1[4 * w + 2]) & 127u) << 16) | ((__float_as_uint(L1[4 * w + 3]) & 127u) << 24);
            pk2[w] = (__float_as_uint(L2[4 * w]) & 127u) | ((__float_as_uint(L2[4 * w + 1]) & 127u) << 8) | ((__float_as_uint(L2[4 * w + 2]) & 127u) << 16) | ((__float_as_uint(L2[4 * w + 3]) & 127u) << 24);
        }
        float mx = R[0];
#pragma unroll
        for (int i = 1; i < 16; ++i) mx = fmaxf(mx, R[i]);
        float e[16]; float se = 0.f;
#pragma unroll
        for (int i = 0; i < 16; ++i) { e[i] = __expf(R[i] - mx); se += e[i]; }
        const float inv = 1.f / se;
        int ex[16];
#pragma unroll
        for (int i = 0; i < 16; ++i) { const unsigned bits = __float_as_uint(R[i]); const unsigned a = (bits >> 4) & 15u, bb = bits & 15u;
            ex[i] = (int)(sel4(pk1[0], pk1[1], pk1[2], pk1[3], a) * 128u + sel4(pk2[0], pk2[1], pk2[2], pk2[3], bb)); e[i] *= inv; }
        const int head = 2 * fq + hh;
        int* ep = EIDX + (size_t)(t0 + fr) * 128 + head * 16; float* gp = GATE + (size_t)(t0 + fr) * 128 + head * 16;
#pragma unroll
        for (int i = 0; i < 16; i += 4) { *(int4*)(ep + i) = make_int4(ex[i], ex[i + 1], ex[i + 2], ex[i + 3]); *(f32x4*)(gp + i) = (f32x4){e[i], e[i + 1], e[i + 2], e[i + 3]}; }
    }
}

__device__ __forceinline__ float gelu_tanh(float x) {
    const float z = 0.7978845608028654f * (x + 0.044715f * x * x * x);
    const float e = __expf(2.f * z); const float th = 1.f - 2.f * __builtin_amdgcn_rcpf(e + 1.f);
    return 0.5f * x * (1.f + th);
}
constexpr int P9_LIST = 0, P9_ACT = 4096, P9_STAGE = 6144, P9_RING = 7168  , P9_VRING = 4096  , P9_WAVE_LDS = 20480, P9_NBATCH = 64, P9_NENT = 1024;
typedef long i64_t;
__device__ __forceinline__ unsigned pk4_fp8(float a, float b, float c, float d) { int t_ = __builtin_amdgcn_cvt_pk_fp8_f32(a, b, 0, false); t_ = __builtin_amdgcn_cvt_pk_fp8_f32(c, d, t_, true); return (unsigned)t_; }

__device__ __forceinline__ void p9_dma_third(const unsigned char* const (&rowp)[4]  , unsigned ringaddr, int t, unsigned buf) {
#pragma unroll
    for (int j = 0; j < 4; ++j) glds16(rowp[j] + 256 * t, (unsigned)__builtin_amdgcn_readfirstlane((int)(ringaddr + buf * 4096u + (unsigned)j * 1024u)));
}
__device__ __forceinline__ void p9_rowptrs(const unsigned char* (&rowp)[4], const LAS unsigned* list, const unsigned char* U6, int batch, int lane) {
#pragma unroll
    for (int j = 0; j < 4; ++j) { const int row = 4 * j + (lane >> 4); const unsigned ent = list[batch * 16 + row];
        rowp[j] = U6 + (size_t)(ent & 0x3fffu) * 512 + 16 * ((lane & 15) ^ row); }
}
typedef int i32x8 __attribute__((ext_vector_type(8)));
template <int M> __device__ __forceinline__ void p9_mma_fp4(f32x4& acc, const LAS unsigned char* ringp, const i32x8 (&B)[8], unsigned hb0, int fr, int fq) {
    const u32x4 g = *(const LAS u32x4*)(ringp + (((hb0 + (unsigned)(M >> 2)) & 3u) << 12) + fr * 256 + ((((unsigned)(4 * (M & 3) + fq)) ^ (unsigned)fr) << 4));
    const i32x8 a = {(int)g.x, (int)g.y, (int)g.z, (int)g.w, 0, 0, 0, 0};
    acc = __builtin_amdgcn_mfma_scale_f32_16x16x128_f8f6f4(a, B[M], acc, 4  , 0  , 0, 0x7f7f7f7f, 0, 0x7f7f7f7f);
}
__device__ __forceinline__ void p9_rowptrs_q(const unsigned char* (&rowp)[2], const LAS unsigned* list, const unsigned char* U4, int batch, int lane) {
#pragma unroll
    for (int j = 0; j < 2; ++j) { const int row = 8 * j + (lane >> 3); const unsigned ent = list[batch * 16 + row];
        rowp[j] = U4 + (size_t)(ent & 0x3fffu) * 512 + 16 * ((lane & 7) ^ ((row >> 1) & 7)); }
}
__device__ __forceinline__ void p9_dma_quarter(const unsigned char* const (&rowp)[2], int q, unsigned bufaddr  ) {
#pragma unroll
    for (int j = 0; j < 2; ++j) glds16(rowp[j] + 128 * q, (unsigned)__builtin_amdgcn_readfirstlane((int)(bufaddr + (unsigned)j * 1024u)));
}
template <int M> __device__ __forceinline__ void p9_mma_q(f32x4& acc, const LAS unsigned char* bufp  , unsigned lofs  , const i32x8 (&B)[8]) {
    const u32x4 g = *(const LAS u32x4*)(bufp + lofs);
    const i32x8 a = {(int)g.x, (int)g.y, (int)g.z, (int)g.w, 0, 0, 0, 0};
    acc = __builtin_amdgcn_mfma_scale_f32_16x16x128_f8f6f4(a, B[M], acc, 4  , 0  , 0, 0x7f7f7f7f, 0, 0x7f7f7f7f);
}
__device__ __forceinline__ void p9_extract(const f32x4& acc, const LAS unsigned* list, LAS float* stage, LAS bf16_t* actl, int n0, int fr, int fq) {
    *(LAS f32x4*)(stage + fr * 16 + 4 * fq) = acc;
    const unsigned ent = list[n0 + fr]; const unsigned s_ = (ent >> 14) & 7u, idx = (ent >> 17) & 127u;
    const float val = stage[(2 * s_) * 16 + fr];
    if (fq == 0) actl[s_ * 128 + idx] = (bf16_t)(cvtpk(val, 0.f) & 0xffffu);
}

__device__ __forceinline__ void phase9_pass(const Params& p, LAS unsigned char* wl  , int tk0  , int lane) {
    const bf16_t* H = (const bf16_t*)(p.ws + WS_H);
    const unsigned char* U8 = p.ws + WS_U8; const unsigned char* V8 = p.ws + WS_V8;
    const float* SU = (const float*)(p.ws + WS_SU); const float* SV = (const float*)(p.ws + WS_SV);
    const int* EIDX = (const int*)(p.ws + WS_EIDX); const float* GATE = (const float*)(p.ws + WS_GATE);
    const float* HMAX = (const float*)(p.ws + WS_HMAX);
    const float* mod = (const float*)(p.ws + WS_MOD);
    LAS unsigned* list = (LAS unsigned*)(wl + P9_LIST);
    LAS bf16_t* actl = (LAS bf16_t*)(wl + P9_ACT);
    LAS float* stage = (LAS float*)(wl + P9_STAGE);
    LAS unsigned char* ringp = wl + P9_RING;
    LAS unsigned* cnt = (LAS unsigned*)ringp;
    LAS unsigned* off = cnt + 64;
    const int fr = lane & 15, fq = lane >> 4;
    cnt[lane] = 0u;
    unsigned offreg;
    {
        unsigned ee[16], rk[16];
#pragma unroll
        for (int i = 0; i < 16; ++i) ee[i] = (unsigned)EIDX[(size_t)(tk0 + (i >> 1)) * 128 + 64 * (i & 1) + lane];
#pragma unroll
        for (int i = 0; i < 16; ++i) rk[i] = atomicAdd((unsigned*)&cnt[(ee[i] >> 11) * 8u + (unsigned)(i >> 1)], 1u);
        { const unsigned c = cnt[lane]; unsigned inc = c;
#pragma unroll
          for (int o = 1; o < 64; o <<= 1) { const unsigned n_ = __shfl_up(inc, o); if (lane >= o) inc += n_; }
          offreg = inc - c; off[lane] = offreg; }
#pragma unroll
        for (int i = 0; i < 16; ++i) list[off[(ee[i] >> 11) * 8u + (unsigned)(i >> 1)] + rk[i]] = ee[i] | ((unsigned)(i >> 1) << 14) | ((unsigned)(64 * (i & 1) + lane) << 17);
    }
    asm volatile("" ::: "memory");
    i32x8 B[8];
    {
        const int slot = fr >> 1;
        const bf16_t* hrow = H + (size_t)(tk0 + slot) * DM + 16 * fq;
        const float mx = HMAX[tk0 + slot];
        const float hs = mx > 0.f ? 224.f / mx : 1.f;
        const bool lo_part = (fr & 1) != 0;
#pragma unroll
        for (int mg = 0; mg < 4; ++mg) {
            u32x4 hv[2][4];
#pragma unroll
            for (int mm = 0; mm < 2; ++mm)
#pragma unroll
                for (int c = 0; c < 4; ++c) hv[mm][c] = *(const u32x4*)(hrow + 128 * (2 * mg + mm) + 64 * (c >> 1) + 8 * (c & 1));
            asm volatile("" ::: "memory");
#pragma unroll
            for (int mm = 0; mm < 2; ++mm) {
                i32x8 w;
#pragma unroll
                for (int c = 0; c < 4; ++c) { const u32x4 a = hv[mm][c];
                    w[2 * c] = (int)pk4_fp8(bflo(a.x) * hs, bfhi(a.x) * hs, bflo(a.y) * hs, bfhi(a.y) * hs);
                    w[2 * c + 1] = (int)pk4_fp8(bflo(a.z) * hs, bfhi(a.z) * hs, bflo(a.w) * hs, bfhi(a.w) * hs); }
                const i32x8 wz = {0, 0, 0, 0, 0, 0, 0, 0};
                B[2 * mg + mm] = lo_part ? wz : w;
            }
        }
    }
    {
        __builtin_amdgcn_s_waitcnt(0);
        const unsigned ringaddr = (unsigned)__builtin_amdgcn_readfirstlane((int)(unsigned)(uintptr_t)ringp);
        const unsigned lofs0 = (unsigned)(fr * 128 + (((unsigned)fq ^ (unsigned)((fr >> 1) & 7)) << 4)), lofs1 = (unsigned)(fr * 128 + (((unsigned)(4 + fq) ^ (unsigned)((fr >> 1) & 7)) << 4));
        const unsigned char* row1[2]; const unsigned char* row2[2];
        p9_rowptrs_q(row2, list, U8, 0, lane); p9_rowptrs_q(row1, list, U8, 1, lane);
        p9_dma_quarter(row2, 0, ringaddr); p9_dma_quarter(row2, 1, ringaddr + 2048u); p9_dma_quarter(row2, 2, ringaddr + 4096u); p9_dma_quarter(row2, 3, ringaddr + 6144u); p9_dma_quarter(row1, 0, ringaddr + 8192u);
        unsigned rb = 0u, wb = 5u * 2048u;
#define P9_UQ(Q, ROWS, QN) do { \
            asm volatile("s_waitcnt vmcnt(8)" ::: "memory"); \
            p9_mma_q<2 * (Q)>(acc, ringp + rb, lofs0, B); p9_mma_q<2 * (Q) + 1>(acc, ringp + rb, lofs1, B); \
            asm volatile("s_waitcnt lgkmcnt(0)" ::: "memory"); \
            p9_dma_quarter(ROWS, (QN), ringaddr + wb); \
            rb = rb + 2048u == 6u * 2048u ? 0u : rb + 2048u; wb = wb + 2048u == 6u * 2048u ? 0u : wb + 2048u; \
        } while (0)
#pragma unroll 1
        for (int b = 0; b < P9_NBATCH; ++b) {
            f32x4 acc = (f32x4){0.f, 0.f, 0.f, 0.f};
            p9_rowptrs_q(row2, list, U8, b + 2 < P9_NBATCH ? b + 2 : P9_NBATCH - 1, lane);
            P9_UQ(0, row1, 1); P9_UQ(1, row1, 2); P9_UQ(2, row1, 3); P9_UQ(3, row2, 0);
            p9_extract(acc, list, stage, actl, 16 * b, fr, fq);
            row1[0] = row2[0]; row1[1] = row2[1];
        }
#undef P9_UQ
        asm volatile("s_waitcnt vmcnt(0)" ::: "memory");
    }
    float sainv[8];
    {
        float av[16]; unsigned en[16]; float amax[8] = {0.f, 0.f, 0.f, 0.f, 0.f, 0.f, 0.f, 0.f};
#pragma unroll
        for (int k = 0; k < 16; ++k) {
            const unsigned ent = list[k * 64 + lane]; const unsigned e = ent & 0x3fffu, s_ = (ent >> 14) & 7u, idx = (ent >> 17) & 127u;
            const float d = __uint_as_float((unsigned)actl[s_ * 128 + idx] << 16);
            const float g = GATE[(size_t)(tk0 + s_) * 128 + idx], hi_ = HMAX[tk0 + s_] * (1.f / 224.f);
            av[k] = gelu_tanh(d * (SU[e] * hi_)) * (g * SV[e]); en[k] = ent;
#pragma unroll
            for (int q = 0; q < 8; ++q) amax[q] = fmaxf(amax[q], s_ == (unsigned)q ? fabsf(av[k]) : 0.f);
        }
        float sa[8];
#pragma unroll
        for (int q = 0; q < 8; ++q) { float m = amax[q];
#pragma unroll
            for (int o = 1; o < 64; o <<= 1) m = fmaxf(m, __shfl_xor(m, o));
            sa[q] = m > 0.f ? 224.f / m : 1.f; sainv[q] = m > 0.f ? m * (1.f / 224.f) : 1.f; }
        asm volatile("s_waitcnt lgkmcnt(0)" ::: "memory");
#pragma unroll
        for (int k = 0; k < 16; ++k) { const unsigned s_ = (en[k] >> 14) & 7u;
            float sc = sa[0];
#pragma unroll
            for (int q = 1; q < 8; ++q) sc = s_ == (unsigned)q ? sa[q] : sc;
            const unsigned b8 = (unsigned)__builtin_amdgcn_cvt_pk_fp8_f32(av[k] * sc, 0.f, 0, false) & 0xffu;
            list[k * 64 + lane] = (en[k] & 0x00ffffffu) | (b8 << 24); }
    }
    {
        LAS unsigned char* vring = wl + P9_VRING;
        f32x16 y[8];
#pragma unroll
        for (int s_ = 0; s_ < 8; ++s_)
#pragma unroll
            for (int r = 0; r < 16; ++r) y[s_][r] = 0.f;
        __builtin_amdgcn_s_waitcnt(0);
        const unsigned ringaddr = (unsigned)__builtin_amdgcn_readfirstlane((int)(unsigned)(uintptr_t)vring);
        const int j5 = lane & 31, kg = lane >> 5;
        const unsigned lo16 = 16u * (unsigned)j5;
        unsigned am[4];
#pragma unroll
        for (int d = 0; d < 4; ++d) am[d] = (kg == (j5 >> 4) && d == ((j5 & 15) >> 2)) ? (0xffu << (8 * (j5 & 3))) : 0u;
#define P9_VISSUE2E(m, ENT) do { const unsigned off_ = (((ENT) & 0x3fffu) << 9) | lo16; \
            const unsigned dst_ = (unsigned)__builtin_amdgcn_readfirstlane((int)(ringaddr + ((((unsigned)(m)) & 31u) << 9))); \
            asm volatile("s_mov_b32 m0, %2\n\ts_nop 0\n\tglobal_load_lds_dwordx4 %0, %1" :: "v"(off_), "s"(V8), "s"(dst_) : "memory", "m0"); } while (0)
#pragma unroll 1
        for (int m_ = 0; m_ < 32; m_ += 2) P9_VISSUE2E(m_, list[m_ + kg]);
        int n = 0, iss = 32;
        asm volatile("s_waitcnt vmcnt(14)" ::: "memory");
        u32x4 bq = *(const LAS u32x4*)(vring + (((unsigned)kg) << 9) + lo16);
        unsigned a0q = list[0], a1q = list[1], enq = list[32 + kg];
#define P9_VPAIR(S, TWO) do { \
            asm volatile("s_waitcnt lgkmcnt(0)" ::: "memory");        \
            const int nn_ = n + ((TWO) ? 2 : 1); const bool doi_ = iss <= nn_ + 30; \
            const unsigned a0_ = __builtin_amdgcn_perm(a0q, a0q, 0x03030303u), a1_ = (TWO) ? __builtin_amdgcn_perm(a1q, a1q, 0x03030303u) : 0u;     \
            const i32x8 am_ = {(int)(a0_ & am[0]), (int)(a0_ & am[1]), (int)(a0_ & am[2]), (int)(a0_ & am[3]), (int)(a1_ & am[0]), (int)(a1_ & am[1]), (int)(a1_ & am[2]), (int)(a1_ & am[3])}; \
            const i32x8 bm_ = {(int)bq.x, (int)bq.y, (int)bq.z, (int)bq.w, 0, 0, 0, 0}; \
            y[S] = __builtin_amdgcn_mfma_scale_f32_32x32x64_f8f6f4(am_, bm_, y[S], 0  , 4  , 0, 0x7f7f7f7f, 0, 0x7f7f7f7f); \
            if (doi_) { P9_VISSUE2E(iss, enq); iss += 2; } \
            asm volatile("s_waitcnt vmcnt(13)" ::: "memory"); \
            bq = *(const LAS u32x4*)(vring + ((((unsigned)(nn_ + kg)) & 31u) << 9) + lo16); \
            a0q = list[nn_]; a1q = list[nn_ + 1]; \
            { const int mi_ = iss + kg; enq = list[mi_ < P9_NENT ? mi_ : P9_NENT - 1]; } \
        } while (0)
#define P9_VSEG(S, END) do { const int end_ = (END); \
            _Pragma("unroll 1") for (; n + 1 < end_; n += 2) P9_VPAIR(S, true); \
            if (n < end_) { P9_VPAIR(S, false); ++n; } } while (0)
#pragma unroll 1
        for (int b = 0; b < 8; ++b) {
            P9_VSEG(0, __builtin_amdgcn_readlane((int)offreg, 8 * b + 1));
            P9_VSEG(1, __builtin_amdgcn_readlane((int)offreg, 8 * b + 2));
            P9_VSEG(2, __builtin_amdgcn_readlane((int)offreg, 8 * b + 3));
            P9_VSEG(3, __builtin_amdgcn_readlane((int)offreg, 8 * b + 4));
            P9_VSEG(4, __builtin_amdgcn_readlane((int)offreg, 8 * b + 5));
            P9_VSEG(5, __builtin_amdgcn_readlane((int)offreg, 8 * b + 6));
            P9_VSEG(6, __builtin_amdgcn_readlane((int)offreg, 8 * b + 7));
            P9_VSEG(7, (b < 7) ? __builtin_amdgcn_readlane((int)offreg, (8 * b + 8) & 63) : P9_NENT);
        }
        asm volatile("s_waitcnt vmcnt(0)" ::: "memory");
        const int bsel = tk0 / SEQ; const int eo = 32 * j5 + 4 * kg;
        f32x4 gtg[4];
#pragma unroll
        for (int u = 0; u < 4; ++u) gtg[u] = *(const f32x4*)(mod + bsel * NMOD + 5 * DM + 8 * u + eo) * *(const f32x4*)(p.g_post_ffn + 8 * u + eo);
#pragma unroll
        for (int s_ = 0; s_ < 8; ++s_) {
            const int t_ = tk0 + s_;
            f32x4 yy[4];
            float ss = 0.f;
#pragma unroll
            for (int u = 0; u < 4; ++u) { yy[u] = (f32x4){y[s_][4 * u], y[s_][4 * u + 1], y[s_][4 * u + 2], y[s_][4 * u + 3]} * sainv[s_]; ss += yy[u][0] * yy[u][0] + yy[u][1] * yy[u][1] + yy[u][2] * yy[u][2] + yy[u][3] * yy[u][3]; }
            const float rstd = rsqrtf(wave_sum_dpp(ss) * (1.f / DM) + RMS_EPS);
            float* orow = p.out + (size_t)t_ * DM + eo; const bf16_t* xrow = (const bf16_t*)(p.ws + WS_X1) + (size_t)t_ * DM + eo;
#pragma unroll
            for (int u = 0; u < 4; ++u) { const u32x2 xb = *(const u32x2*)(xrow + 8 * u); const f32x4 x1 = {bflo(xb.x), bfhi(xb.x), bflo(xb.y), bfhi(xb.y)}; *(f32x4*)(orow + 8 * u) = x1 + gtg[u] * (yy[u] * rstd); }
        }
        asm volatile("s_waitcnt lgkmcnt(0)" ::: "memory");
    }
}

#define XB_TMO      128
#define XB_XCNT(j)  (256  + 64 * (j))
#define XB_XSUB(j)  (1280 + 64 * (j))
#define XB_XGEN(j)  (2304 + 64 * (j))
#define XB_TOP      3328
#define XB_TOPGEN   3392
#define XCD_BAR_WORDS 3456
#define XB_SPIN_CAP (1u << 18)

__device__ __forceinline__ unsigned xb_ld(unsigned* p)              { return __hip_atomic_load(p, __ATOMIC_RELAXED, __HIP_MEMORY_SCOPE_AGENT); }
__device__ __forceinline__ unsigned xb_add(unsigned* p, unsigned v) { return __hip_atomic_fetch_add(p, v, __ATOMIC_RELAXED, __HIP_MEMORY_SCOPE_AGENT); }
__device__ __forceinline__ unsigned xb_xcc_id() { return (unsigned)__builtin_amdgcn_s_getreg((3 << 11) | 20) & 0xFu; }
#define XB_SPIN(cond, bar) do { unsigned _sp = 0; while (cond) { __builtin_amdgcn_s_sleep(1); \
    if ((++_sp & 255u) == 0u) { if (xb_ld(&(bar)[XB_TMO])) break; if (_sp > XB_SPIN_CAP) { atomicAdd(&(bar)[XB_TMO], 1u); break; } } } } while (0)

struct XcdBarrier {
    unsigned* bar; unsigned x;
    volatile LAS unsigned* st;
};

__device__ __forceinline__ XcdBarrier xcd_barrier_post(unsigned* bar, volatile LAS unsigned* st) {
    XcdBarrier b; b.bar = bar; b.x = xb_xcc_id(); b.st = st;
    if (threadIdx.x == 0) (void)xb_add(&bar[XB_XCNT(b.x)], 1u);
    return b;
}
__device__ __forceinline__ void xcd_barrier_complete(unsigned* bar, unsigned x, unsigned& nloc, unsigned& nx) {
    const unsigned G = gridDim.x * gridDim.y * gridDim.z;
    unsigned sum, cnt, mine, sp = 0u;
    for (;;) {
        sum = 0u; cnt = 0u; mine = 0u;
#pragma unroll
        for (unsigned j = 0; j < 16; ++j) { const unsigned c = xb_ld(&bar[XB_XCNT(j)]); sum += c; cnt += (c > 0u) ? 1u : 0u; mine = (j == x) ? c : mine; }
        if (sum == G) break;
        __builtin_amdgcn_s_sleep(1);
        if ((++sp & 255u) == 0u) { if (xb_ld(&bar[XB_TMO])) break; if (sp > XB_SPIN_CAP) { atomicAdd(&bar[XB_TMO], 1u); break; } }
    }
    nloc = mine > 0u ? mine : 1u; nx = cnt > 0u ? cnt : 1u;
}

__device__ __forceinline__ void xcd_barrier(const XcdBarrier& b) {
    asm volatile("s_waitcnt vmcnt(0)" ::: "memory");
    __syncthreads();
    if (threadIdx.x == 0) {
        unsigned* bar = b.bar;
        __builtin_amdgcn_s_waitcnt(0);
        unsigned nloc = b.st[0], nx = b.st[1];
        if (nloc == 0u) { xcd_barrier_complete(bar, b.x, nloc, nx); b.st[0] = nloc; b.st[1] = nx; }
        const unsigned old = xb_add(&bar[XB_XSUB(b.x)], 1u);
        const unsigned gen = old / nloc;
        if (old + 1u == (gen + 1u) * nloc) {
            __builtin_amdgcn_fence(__ATOMIC_RELEASE, "agent");
            asm volatile("s_waitcnt vmcnt(0)" ::: "memory");
            const unsigned og = xb_add(&bar[XB_TOP], 1u);
            const unsigned tg = og / nx;
            if (og + 1u == (tg + 1u) * nx) xb_add(&bar[XB_TOPGEN], 1u);
            else XB_SPIN(xb_ld(&bar[XB_TOPGEN]) == tg, bar);
            __builtin_amdgcn_fence(__ATOMIC_ACQUIRE, "agent");
            xb_add(&bar[XB_XGEN(b.x)], 1u);
            asm volatile("s_waitcnt vmcnt(0)" ::: "memory");
        } else {
            XB_SPIN(xb_ld(&bar[XB_XGEN(b.x)]) == gen, bar);
            __builtin_amdgcn_fence(__ATOMIC_ACQUIRE, "agent");
            asm volatile("s_waitcnt vmcnt(0)" ::: "memory");
        }
    }
    __syncthreads();
}


__global__ void __launch_bounds__(NTHREADS, 2) fwd_kernel(Params p) {
    extern __shared__ __attribute__((aligned(16))) unsigned char lds_raw[];
    LAS unsigned char* lds = (LAS unsigned char*)lds_raw;
    volatile LAS unsigned* bst = (volatile LAS unsigned*)(lds + LDS_BYTES - 16);
    if (threadIdx.x < 4) bst[threadIdx.x] = 0u;
    __syncthreads();
    const XcdBarrier xbar = xcd_barrier_post((unsigned*)(p.ws + WS_BAR), bst);
#define GRID_BAR() xcd_barrier(xbar)

    REPEAT(1, phase0(p, lds));
    GRID_BAR();
    REPEAT(2, phase1(p, lds));
    GRID_BAR();
    scan_kb(p, lds);
    REPEAT(3, {
        pg8::Gemm g{(const bf16_t*)(p.ws + WS_H), (const bf16_t*)(p.ws + WS_WTIN), T, NPROJ, DM};
        pg8::StaticOrder S; S.init(T, NPROJ, gridDim.x, blockIdx.x);
        pg8::EpiBf16 E{(bf16_t*)(p.ws + WS_PROJ), NPROJ, 0xC3u, C2};
        pg8::gemm_phase<pg8::EpiBf16, pg8::StaticOrder>(lds, g, S, E);
    });
    GRID_BAR();
    REPEAT(4, { fox_prepass(p); phase_swa(p, lds); });
    GRID_BAR();
    REPEAT(5, phase_fox(p, lds));
    GRID_BAR();
    REPEAT(6, {
        pg8::Gemm g{(const bf16_t*)(p.ws + WS_ATT), (const bf16_t*)(p.ws + WS_WTOUT), T, DM, DM};
        pg8::StaticOrder S; S.init(T, DM, gridDim.x, blockIdx.x);
        pg8::EpiBf16 E{(bf16_t*)(p.ws + WS_PROJ), DM, 0u, 1.f};
        pg8::gemm_phase<pg8::EpiBf16, pg8::StaticOrder>(lds, g, S, E);
    });
    GRID_BAR();
    REPEAT(7, phase6(p));
    GRID_BAR();
    REPEAT(8, {
        pg8::Gemm g{(const bf16_t*)(p.ws + WS_H), (const bf16_t*)(p.ws + WS_WTQ), T, 2048, DM};
        pg8::StaticOrder S; S.init(T, 2048, gridDim.x, blockIdx.x);
        pg8::EpiBf16 E{(bf16_t*)(p.ws + WS_PROJ), 2048, 0u, 1.f};
        pg8::gemm_phase<pg8::EpiBf16, pg8::StaticOrder>(lds, g, S, E);
    });
    GRID_BAR();
    for (int tb = blockIdx.x * 128; tb < T; tb += gridDim.x * 128) {
        REPEAT(9, { const int t8 = fresh_tid(); phase8_block(p, lds, tb + 16 * (t8 >> 6), __builtin_amdgcn_readfirstlane(t8 >> 6), t8 & 63); });
        __builtin_amdgcn_fence(__ATOMIC_RELEASE, "workgroup");
        asm volatile("s_waitcnt vmcnt(0)" ::: "memory");
        __builtin_amdgcn_fence(__ATOMIC_ACQUIRE, "workgroup");
        __syncthreads();
#pragma unroll 1
        for (int i = 0; i < 2; ++i) { const int t9 = fresh_tid(); phase9_pass(p, lds + (t9 >> 6) * P9_WAVE_LDS, tb + 16 * (t9 >> 6) + 8 * i, t9 & 63); }
    }
}

extern "C" void kernel_launch(void* const* d_in, const int* in_sizes, int n_in, void* d_out, int out_size, void* d_ws, size_t ws_size, hipStream_t stream) {
    static int grid_blocks = 0;
    if (grid_blocks == 0) {
        if (n_in != 16 || out_size != T * DM || ws_size < WS_END) { fprintf(stderr, "kernel_launch: unexpected shapes (n_in %d out %d ws %zu)\n", n_in, out_size, ws_size); grid_blocks = -1; return; }
        int dev = 0, cus = 0, per_cu = 0;
        (void)hipGetDevice(&dev);
        (void)hipDeviceGetAttribute(&cus, hipDeviceAttributeMultiprocessorCount, dev);
        (void)hipFuncSetAttribute((const void*)fwd_kernel, hipFuncAttributeMaxDynamicSharedMemorySize, LDS_BYTES);
        (void)hipOccupancyMaxActiveBlocksPerMultiprocessor(&per_cu, (const void*)fwd_kernel, NTHREADS, LDS_BYTES);
        if (per_cu < 1) { fprintf(stderr, "kernel_launch: occupancy query says %d blocks per CU\n", per_cu); per_cu = 1; }
        grid_blocks = cus;
        fprintf(stderr, "kernel_launch: grid %d (cus %d, per_cu %d)\n", grid_blocks, cus, per_cu);
    }
    if (grid_blocks < 0) return;
    Params p{};
    p.x = (const float*)d_in[0]; p.c = (const float*)d_in[1]; p.w_ada = (const float*)d_in[2]; p.b_ada = (const float*)d_in[3];
    p.g_pre_mix = (const float*)d_in[4]; p.g_post_mix = (const float*)d_in[5]; p.g_pre_ffn = (const float*)d_in[6]; p.g_post_ffn = (const float*)d_in[7];
    p.w_in = (const float*)d_in[8]; p.b_fgate = (const float*)d_in[9]; p.swa_sinks = (const float*)d_in[10]; p.w_out = (const float*)d_in[11];
    p.w_query = (const float*)d_in[12]; p.sub_keys = (const float*)d_in[13]; p.w_u = (const float*)d_in[14]; p.w_v = (const float*)d_in[15];
    p.out = (float*)d_out; p.ws = (unsigned char*)d_ws;
    (void)hipMemsetAsync((unsigned char*)d_ws + WS_BAR, 0, 16384, stream);
    void* args[] = {&p};
    hipError_t e = hipLaunchCooperativeKernel((void*)fwd_kernel, dim3(grid_blocks), dim3(NTHREADS), args, LDS_BYTES, stream);
    if (e != hipSuccess) fprintf(stderr, "kernel_launch: cooperative launch failed: %s (grid %d)\n", hipGetErrorString(e), grid_blocks);
}
```

```cpp
#include <hip/hip_runtime.h>
#include <hip/hip_cooperative_groups.h>
#include <cstdio>
#include <cstdint>
namespace cg = cooperative_groups;

#define LAS __attribute__((address_space(3)))
typedef unsigned short bf16_t;
typedef short bf16x8 __attribute__((ext_vector_type(8)));
typedef short s16x4 __attribute__((ext_vector_type(4)));
typedef float f32x4 __attribute__((ext_vector_type(4)));
typedef float f32x16 __attribute__((ext_vector_type(16)));
typedef unsigned u32x4 __attribute__((ext_vector_type(4)));
typedef unsigned u32x2 __attribute__((ext_vector_type(2)));
typedef float f32x2_t __attribute__((ext_vector_type(2)));
typedef __bf16 bf16x2_t __attribute__((ext_vector_type(2)));

constexpr int BATCH = 4, SEQ = 8192, DM = 1024, T = BATCH * SEQ;
constexpr int NPROJ = 2304, INW = 2312;
constexpr int NMOD = 6 * DM;
constexpr float RMS_EPS = 1e-6f;
constexpr float LOG2E = 1.4426950408889634f;
constexpr float C2 = 0.125f * LOG2E;
constexpr float NEGBIG = -1e30f;

constexpr size_t MiB = 1u << 20;
constexpr size_t WS_MOD = 0, WS_WF = 128 * 1024, WS_KT = 256 * 1024  , WS_BAR = 512 * 1024  , WS_HMAX = 640 * 1024  , WS_LS = 1 * MiB, WS_KB = 2 * MiB;
constexpr size_t WS_WTIN = 4 * MiB, WS_WTOUT = 10 * MiB, WS_WTQ = 12 * MiB, WS_SK = 16 * MiB;
constexpr size_t WS_U8 = 32 * MiB, WS_V8 = 48 * MiB, WS_SU = 64 * MiB, WS_SV = 64 * MiB + 65536, WS_H = 96 * MiB, WS_ATT = 160 * MiB, WS_PROJ = 224 * MiB;
constexpr size_t WS_EIDX = 160 * MiB, WS_GATE = 176 * MiB  , WS_X1 = 352 * MiB, WS_END = 480 * MiB;

constexpr int NTHREADS = 512, NWAVES = 8;
#define REP_PHASE 0
#define REPEAT(k, ...) do { __VA_ARGS__; if (REP_PHASE == (k)) { __syncthreads(); __VA_ARGS__; } } while (0)
constexpr int LDS_BYTES = 163840;

__device__ __forceinline__ unsigned cvtpk(float lo, float hi) { f32x2_t v = {lo, hi}; bf16x2_t b = __builtin_convertvector(v, bf16x2_t); return __builtin_bit_cast(unsigned, b); }
__device__ __forceinline__ float bflo(unsigned w) { return __uint_as_float(w << 16); }
__device__ __forceinline__ float bfhi(unsigned w) { return __uint_as_float(w & 0xffff0000u); }
__device__ __forceinline__ float wave_sum(float v) {
#pragma unroll
    for (int o = 1; o < 64; o <<= 1) v += __shfl_xor(v, o);
    return v;
}
__device__ __forceinline__ float vmaxf(float a, float b) { float r; asm("v_max_f32_e32 %0, %1, %2" : "=v"(r) : "v"(a), "v"(b)); return r; }
__device__ __forceinline__ float vminf(float a, float b) { float r; asm("v_min_f32_e32 %0, %1, %2" : "=v"(r) : "v"(a), "v"(b)); return r; }
__device__ __forceinline__ int fresh_tid() { int t = threadIdx.x; asm volatile("" : "+v"(t)); return t; }
__device__ __forceinline__ int crow(int r, int hi) { return (r & 3) + 8 * (r >> 2) + 4 * hi; }

namespace pg8 {
constexpr int BM = 256, BK = 64, HALF = 128, HTB = HALF * BK * 2, STAGE_BYTES = 8 * HTB, NXCD = 8, WGM = 8;
__host__ __device__ __forceinline__ int lds_byte(int r, int c) { const int st = (r >> 4) * 2 + (c >> 5), rr = r & 15, cc = c & 31, ob = rr * 64 + cc * 2; return st * 1024 + (ob ^ (((ob >> 9) & 1) << 5)); }
__host__ __device__ __forceinline__ void stage_rc(int b, int& R, int& C) { const int st = b / 1024, sb = b % 1024, swz = sb ^ (((sb >> 9) & 1) << 5); R = (st >> 1) * 16 + swz / 64; C = (st & 1) * 32 + (swz % 64) / 2; }
__host__ __device__ __forceinline__ int perm32(int rho) { const int n = rho >> 4, i = rho & 15; return 8 * (i >> 2) + 4 * n + (i & 3); }
struct Unit { int pm, pn; };
struct Gemm { const bf16_t* A; const bf16_t* Bt; int M, N, K; };
struct StaticOrder {
    int nM, nN, nwg, G, c;
    __device__ void init(int M, int N, int G_, int c_) { nM = M / BM; nN = N / BM; nwg = nM * nN; G = G_; c = c_; }
    __device__ bool next(int i, Unit& u) const {
        const long L = (long)i * G + c; if (L >= nwg) return false;
        int wgid = (int)L; { const int q = nwg / NXCD, r = nwg % NXCD, xcd = wgid % NXCD, off = wgid / NXCD; wgid = (xcd < r ? xcd * (q + 1) : r * (q + 1) + (xcd - r) * q) + off; }
        const int nig = WGM * nN, gid = wgid / nig, fm = gid * WGM, gsz = (nM - fm) < WGM ? (nM - fm) : WGM;
        u.pm = fm + ((wgid % nig) % gsz); u.pn = (wgid % nig) / gsz; return true;
    }
};
struct EpiBf16 {
    static constexpr bool PERM = true;
    bf16_t* O; int ldc; unsigned scale_mask; float sc;
    __device__ __forceinline__ void operator()(const f32x4 (&acc)[2][2][4][2], const Unit& u, int wr, int wc, int fr, int fq) const {
        const int row0 = u.pm * BM + wr * 64 + fr; const int col0 = u.pn * BM + wc * 32 + 8 * fq;
        const float s = ((scale_mask >> u.pn) & 1u) ? sc : 1.f;
#pragma unroll
        for (int ai = 0; ai < 2; ++ai)
#pragma unroll
            for (int m = 0; m < 4; ++m) { bf16_t* rowp = O + (size_t)(row0 + ai * HALF + m * 16) * ldc + col0;
#pragma unroll
                for (int bj = 0; bj < 2; ++bj) { const f32x4 v0 = acc[ai][bj][m][0] * s, v1 = acc[ai][bj][m][1] * s;
                    u32x4 w; w.x = cvtpk(v0[0], v0[1]); w.y = cvtpk(v0[2], v0[3]); w.z = cvtpk(v1[0], v1[1]); w.w = cvtpk(v1[2], v1[3]);
                    *(u32x4*)(rowp + bj * HALF) = w; } }
    }
};

template <class Epi, class Sched>
__device__ __forceinline__ void gemm_phase(LAS unsigned char* lds, const Gemm g, const Sched& S, const Epi& E) {
    const int tid = fresh_tid(), wid = __builtin_amdgcn_readfirstlane(tid >> 6), lane = tid & 63, wr = wid >> 2, wc = wid & 3, fr = lane & 15, fq = lane >> 4;
    const int K = g.K, nt = K / BK;
    unsigned voffA[2], voffB[2];
#pragma unroll
    for (int i = 0; i < 2; ++i) { int R, C; stage_rc(tid * 16 + i * 8192, R, C); const int Rb = Epi::PERM ? ((R & ~31) + perm32(R & 31)) : R;
        voffA[i] = (unsigned)(R * K + C) * 2u; voffB[i] = (unsigned)(Rb * K + C) * 2u; }
    const size_t kstep = (size_t)(BK * 2);
    const size_t hstep = (size_t)HALF * K * 2;
    const size_t tstep = 2 * hstep;
    const unsigned ldsw = (unsigned)wid * 1024u;
    const int aoff = lds_byte(wr * 64 + fr, fq * 8), boff = lds_byte(wc * 32 + fr, fq * 8);
#define PG8_SA(b, h) (((b) * 2 + (h)) * HTB)
#define PG8_SB(b, h) ((4 + (b) * 2 + (h)) * HTB)
#define PG8_STAGE(bufoff, gbase, voff) do { _Pragma("unroll") for (int _i = 0; _i < 2; ++_i) \
        __builtin_amdgcn_global_load_lds((const unsigned*)((const char*)(gbase) + (voff)[_i]), (LAS unsigned*)(lds + (bufoff) + ldsw + _i * 8192), 16, 0, 0); } while (0)
#define PG8_LDA(dst, b, h) do { _Pragma("unroll") for (int m = 0; m < 4; ++m) _Pragma("unroll") for (int k = 0; k < 2; ++k) dst[m][k] = *(const LAS bf16x8*)(lds + PG8_SA(b, h) + aoff + m * 2048 + k * 1024); } while (0)
#define PG8_LDB(dst, b, h) do { _Pragma("unroll") for (int n = 0; n < 2; ++n) _Pragma("unroll") for (int k = 0; k < 2; ++k) dst[n][k] = *(const LAS bf16x8*)(lds + PG8_SB(b, h) + boff + n * 2048 + k * 1024); } while (0)
#define PG8_MMA(ai, bj, At, Bt) do { __builtin_amdgcn_s_setprio(1); _Pragma("unroll") for (int m = 0; m < 4; ++m) _Pragma("unroll") for (int n = 0; n < 2; ++n) _Pragma("unroll") for (int k = 0; k < 2; ++k) \
        acc[ai][bj][m][n] = __builtin_amdgcn_mfma_f32_16x16x32_bf16(Bt[n][k], At[m][k], acc[ai][bj][m][n], 0, 0, 0); __builtin_amdgcn_s_setprio(0); } while (0)
#define PG8_WAIT_V(n) asm volatile("s_waitcnt vmcnt(" #n ")" ::: "memory")
#define PG8_WAIT_L(n) asm volatile("s_waitcnt lgkmcnt(" #n ")" ::: "memory")
#define PG8_BAR __builtin_amdgcn_s_barrier()
#define PG8_SCHED __builtin_amdgcn_sched_barrier(0)
    Unit cur, nxt; int ui = 0;
    if (!S.next(0, cur)) return;
    f32x4 acc[2][2][4][2];
#pragma unroll
    for (int a = 0; a < 2; ++a)
#pragma unroll
        for (int b = 0; b < 2; ++b)
#pragma unroll
            for (int m = 0; m < 4; ++m)
#pragma unroll
                for (int n = 0; n < 2; ++n) acc[a][b][m][n] = (f32x4){0.f, 0.f, 0.f, 0.f};
    bf16x8 At[4][2], B0[2][2], B1[2][2];
    const char* cA = (const char*)g.A + (size_t)cur.pm * tstep; const char* cB = (const char*)g.Bt + (size_t)cur.pn * tstep;
    PG8_STAGE(PG8_SB(0, 0), cB, voffB); PG8_STAGE(PG8_SA(0, 0), cA, voffA); PG8_STAGE(PG8_SB(0, 1), cB + hstep, voffB); PG8_STAGE(PG8_SA(0, 1), cA + hstep, voffA);
    if (wr == 1) PG8_BAR;
    PG8_WAIT_V(4); PG8_BAR;
    PG8_STAGE(PG8_SB(1, 0), cB + kstep, voffB); PG8_STAGE(PG8_SA(1, 0), cA + kstep, voffA); PG8_STAGE(PG8_SB(1, 1), cB + hstep + kstep, voffB);
    PG8_WAIT_V(6); PG8_BAR;
    for (;;) {
        const bool has_next = S.next(ui + 1, nxt);
        const char* nA = has_next ? (const char*)g.A + (size_t)nxt.pm * tstep : cA; const char* nB = has_next ? (const char*)g.Bt + (size_t)nxt.pn * tstep : cB;
        for (int t = 0; t < nt; t += 2) {
            const bool last = (t == nt - 2);
            const char* a1 = cA + (size_t)(t + 1) * kstep;
            const char* a2 = last ? nA : cA + (size_t)(t + 2) * kstep; const char* b2 = last ? nB : cB + (size_t)(t + 2) * kstep;
            const char* a3 = a2 + kstep; const char* b3 = b2 + kstep;
            PG8_LDB(B0, 0, 0); PG8_SCHED; PG8_LDA(At, 0, 0); PG8_STAGE(PG8_SA(1, 1), a1 + hstep, voffA);
            PG8_WAIT_L(8); PG8_BAR; PG8_WAIT_L(0); PG8_MMA(0, 0, At, B0); PG8_BAR; PG8_SCHED;
            PG8_LDB(B1, 0, 1); PG8_STAGE(PG8_SB(0, 0), b2, voffB);
            PG8_BAR; PG8_WAIT_L(0); PG8_MMA(0, 1, At, B1); PG8_BAR;
            PG8_LDA(At, 0, 1); PG8_STAGE(PG8_SA(0, 0), a2, voffA);
            PG8_BAR; PG8_WAIT_L(0); PG8_MMA(1, 0, At, B0); PG8_BAR; PG8_SCHED;
            PG8_STAGE(PG8_SB(0, 1), b2 + hstep, voffB);
            PG8_WAIT_V(6); PG8_BAR; PG8_MMA(1, 1, At, B1); PG8_BAR;
            PG8_LDB(B0, 1, 0); PG8_SCHED; PG8_LDA(At, 1, 0); PG8_STAGE(PG8_SA(0, 1), a2 + hstep, voffA);
            PG8_WAIT_L(8); PG8_BAR; PG8_WAIT_L(0); PG8_MMA(0, 0, At, B0); PG8_BAR; PG8_SCHED;
            PG8_LDB(B1, 1, 1); PG8_STAGE(PG8_SB(1, 0), b3, voffB);
            PG8_BAR; PG8_WAIT_L(0); PG8_MMA(0, 1, At, B1); PG8_BAR;
            PG8_LDA(At, 1, 1); PG8_STAGE(PG8_SA(1, 0), a3, voffA);
            PG8_BAR; PG8_WAIT_L(0); PG8_MMA(1, 0, At, B0); PG8_BAR; PG8_SCHED;
            PG8_STAGE(PG8_SB(1, 1), b3 + hstep, voffB);
            PG8_WAIT_V(6); PG8_BAR; PG8_MMA(1, 1, At, B1); PG8_BAR;
        }
        E(acc, cur, wr, wc, fr, fq);
        if (!has_next) break;
#pragma unroll
        for (int a = 0; a < 2; ++a)
#pragma unroll
            for (int b = 0; b < 2; ++b)
#pragma unroll
                for (int m = 0; m < 4; ++m)
#pragma unroll
                    for (int n = 0; n < 2; ++n) acc[a][b][m][n] = (f32x4){0.f, 0.f, 0.f, 0.f};
        cur = nxt; cA = nA; cB = nB; ++ui;
    }
    PG8_WAIT_V(0);
    if (wr == 0) PG8_BAR;
    PG8_BAR;
#undef PG8_SA
#undef PG8_SB
#undef PG8_STAGE
#undef PG8_LDA
#undef PG8_LDB
#undef PG8_MMA
#undef PG8_WAIT_V
#undef PG8_WAIT_L
#undef PG8_BAR
#undef PG8_SCHED
}
}

struct Params {
    const float *x, *c, *w_ada, *b_ada, *g_pre_mix, *g_post_mix, *g_pre_ffn, *g_post_ffn, *w_in, *b_fgate, *swa_sinks, *w_out, *w_query, *sub_keys, *w_u, *w_v;
    float* out; unsigned char* ws;
};

__device__ __forceinline__ void phase0(const Params& p, LAS unsigned char* lds) {
    const int tid = fresh_tid();
    float* mod = (float*)(p.ws + WS_MOD);
    if (blockIdx.x < NMOD / 32) {
        LAS float* sc = (LAS float*)lds;
        LAS float* red = (LAS float*)(lds + 16384);
        for (int i = tid; i < BATCH * DM; i += NTHREADS) { const float cv = p.c[i]; sc[i] = cv / (1.f + __expf(-cv)); }
        __syncthreads();
        const int cl = tid & 31, ks = tid >> 5, col = blockIdx.x * 32 + cl;
        float a0 = 0.f, a1 = 0.f, a2 = 0.f, a3 = 0.f;
#pragma unroll 32
        for (int k = ks * 64; k < ks * 64 + 64; ++k) { const float w = p.w_ada[(size_t)k * NMOD + col]; a0 += sc[k] * w; a1 += sc[DM + k] * w; a2 += sc[2 * DM + k] * w; a3 += sc[3 * DM + k] * w; }
        red[(ks * 4 + 0) * 32 + cl] = a0; red[(ks * 4 + 1) * 32 + cl] = a1; red[(ks * 4 + 2) * 32 + cl] = a2; red[(ks * 4 + 3) * 32 + cl] = a3;
        __syncthreads();
        if (tid < 128) { const int b = tid >> 5, c2 = tid & 31; float s = 0.f;
#pragma unroll
            for (int k = 0; k < 16; ++k) s += red[(k * 4 + b) * 32 + c2];
            mod[b * NMOD + blockIdx.x * 32 + c2] = s + p.b_ada[blockIdx.x * 32 + c2]; }
        __syncthreads();
    }
    const size_t gt = (size_t)blockIdx.x * NTHREADS + tid, ng = (size_t)gridDim.x * NTHREADS;
    {
        const int lane = tid & 63, gw = blockIdx.x * NWAVES + (tid >> 6), ngw = gridDim.x * NWAVES;
        unsigned char* U6 = p.ws + WS_U8; unsigned char* V8 = p.ws + WS_V8; float* SU = (float*)(p.ws + WS_SU); float* SV = (float*)(p.ws + WS_SV);
        for (int r = gw; r < 8192 + 8192; r += ngw) {
            const bool isv = r < 8192;
            const int e = 2 * (isv ? r : r - 8192) + (lane >> 5), l32 = lane & 31;
            const float* src = (isv ? p.w_v : p.w_u) + (size_t)e * DM + 32 * l32;
            f32x4 q[8]; float mx = 0.f;
#pragma unroll
            for (int k = 0; k < 8; ++k) { q[k] = *(const f32x4*)(src + 4 * k);
#pragma unroll
                for (int i = 0; i < 4; ++i) mx = fmaxf(mx, fabsf(q[k][i])); }
#pragma unroll
            for (int o = 1; o < 32; o <<= 1) mx = fmaxf(mx, __shfl_xor(mx, o));
            const float sc = mx > 0.f ? 6.f / mx : 1.f, isc = mx > 0.f ? mx * (1.f / 6.f) : 1.f;
            u32x4 w;
#pragma unroll
            for (int d = 0; d < 4; ++d) { unsigned t_ = 0u;
                t_ = __builtin_amdgcn_cvt_scalef32_pk_fp4_f32(t_, q[2 * d][0] * sc, q[2 * d][1] * sc, 1.0f, 0);
                t_ = __builtin_amdgcn_cvt_scalef32_pk_fp4_f32(t_, q[2 * d][2] * sc, q[2 * d][3] * sc, 1.0f, 1);
                t_ = __builtin_amdgcn_cvt_scalef32_pk_fp4_f32(t_, q[2 * d + 1][0] * sc, q[2 * d + 1][1] * sc, 1.0f, 2);
                t_ = __builtin_amdgcn_cvt_scalef32_pk_fp4_f32(t_, q[2 * d + 1][2] * sc, q[2 * d + 1][3] * sc, 1.0f, 3);
                w[d] = t_; }
            *(u32x4*)((isv ? V8 : U6) + (size_t)e * 512 + 16 * l32) = w;
            if (l32 == 0) (isv ? SV : SU)[e] = isc;
        }
    }
    {
        bf16_t* SK = (bf16_t*)(p.ws + WS_SK); const size_t n8 = 16 * 128 * 128 / 8;
        for (size_t i = gt; i < n8; i += ng) { const float* src = p.sub_keys + i * 8; const f32x4 a = *(const f32x4*)src, b = *(const f32x4*)(src + 4);
            u32x4 w; w.x = cvtpk(a[0], a[1]); w.y = cvtpk(a[2], a[3]); w.z = cvtpk(b[0], b[1]); w.w = cvtpk(b[2], b[3]); *(u32x4*)(SK + i * 8) = w; }
    }
    {
        bf16_t* WTI = (bf16_t*)(p.ws + WS_WTIN); bf16_t* WTO = (bf16_t*)(p.ws + WS_WTOUT); bf16_t* WTQ = (bf16_t*)(p.ws + WS_WTQ);
        const size_t nI = (size_t)NPROJ * 128, nO = (size_t)1024 * 128, nQ = (size_t)2048 * 128;
        for (size_t i0_ = gt; i0_ < nI + nO + nQ; i0_ += 3 * ng) {
            float v[3][8]; bf16_t* dst[3];
#pragma unroll
            for (int q = 0; q < 3; ++q) {
                const size_t i = i0_ + (size_t)q * ng; const bool ok = i < nI + nO + nQ; const size_t ii = ok ? i : gt;
                const float* W; bf16_t* WT; int N, pitch, n, kc, sc_;
                if (ii < nI) { N = NPROJ; pitch = INW; W = p.w_in; WT = WTI; n = (int)(ii % N); kc = (int)(ii / N); sc_ = n < 1536 ? n : n + 8; }
                else if (ii < nI + nO) { const size_t j = ii - nI; N = 1024; pitch = 1024; W = p.w_out; WT = WTO; n = (int)(j % N); kc = (int)(j / N); sc_ = n; }
                else { const size_t j = ii - nI - nO; N = 2048; pitch = 2048; W = p.w_query; WT = WTQ; n = (int)(j % N); kc = (int)(j / N); sc_ = n; }
#pragma unroll
                for (int j = 0; j < 8; ++j) v[q][j] = W[(size_t)(kc * 8 + j) * pitch + sc_];
                dst[q] = ok ? WT + (size_t)n * 1024 + kc * 8 : nullptr;
            }
#pragma unroll
            for (int q = 0; q < 3; ++q) if (dst[q]) { u32x4 w; w.x = cvtpk(v[q][0], v[q][1]); w.y = cvtpk(v[q][2], v[q][3]); w.z = cvtpk(v[q][4], v[q][5]); w.w = cvtpk(v[q][6], v[q][7]); *(u32x4*)dst[q] = w; }
        }
    }
    {
        float* WF = (float*)(p.ws + WS_WF);
        for (size_t i = gt; i < 8 * 1024; i += ng) { const int hd = (int)(i & 7), k = (int)(i >> 3); WF[hd * 1024 + k] = p.w_in[(size_t)k * INW + 1536 + hd]; }
    }
}

__device__ __forceinline__ void ld16(const float* rowp, int lane, float (&v)[16]) {
    const f32x4 a = *(const f32x4*)(rowp + 8 * lane), b = *(const f32x4*)(rowp + 8 * lane + 4), c = *(const f32x4*)(rowp + 512 + 8 * lane), d = *(const f32x4*)(rowp + 512 + 8 * lane + 4);
#pragma unroll
    for (int i = 0; i < 4; ++i) { v[i] = a[i]; v[4 + i] = b[i]; v[8 + i] = c[i]; v[12 + i] = d[i]; }
}
__device__ __forceinline__ void st16_bf16(bf16_t* rowp, int lane, const float (&v)[16]) {
    u32x4 w0, w1; w0.x = cvtpk(v[0], v[1]); w0.y = cvtpk(v[2], v[3]); w0.z = cvtpk(v[4], v[5]); w0.w = cvtpk(v[6], v[7]);
    w1.x = cvtpk(v[8], v[9]); w1.y = cvtpk(v[10], v[11]); w1.z = cvtpk(v[12], v[13]); w1.w = cvtpk(v[14], v[15]);
    *(u32x4*)(rowp + 8 * lane) = w0; *(u32x4*)(rowp + 512 + 8 * lane) = w1;
}
__device__ __forceinline__ void ld16_bf16(const bf16_t* rowp, int lane, float (&v)[16]) {
    const u32x4 w0 = *(const u32x4*)(rowp + 8 * lane), w1 = *(const u32x4*)(rowp + 512 + 8 * lane);
    v[0] = bflo(w0.x); v[1] = bfhi(w0.x); v[2] = bflo(w0.y); v[3] = bfhi(w0.y); v[4] = bflo(w0.z); v[5] = bfhi(w0.z); v[6] = bflo(w0.w); v[7] = bfhi(w0.w);
    v[8] = bflo(w1.x); v[9] = bfhi(w1.x); v[10] = bflo(w1.y); v[11] = bfhi(w1.y); v[12] = bflo(w1.z); v[13] = bfhi(w1.z); v[14] = bflo(w1.w); v[15] = bfhi(w1.w);
}
__device__ __forceinline__ void st16(float* rowp, int lane, const float (&v)[16]) {
    *(f32x4*)(rowp + 8 * lane) = (f32x4){v[0], v[1], v[2], v[3]}; *(f32x4*)(rowp + 8 * lane + 4) = (f32x4){v[4], v[5], v[6], v[7]};
    *(f32x4*)(rowp + 512 + 8 * lane) = (f32x4){v[8], v[9], v[10], v[11]}; *(f32x4*)(rowp + 512 + 8 * lane + 4) = (f32x4){v[12], v[13], v[14], v[15]};
}

#define DPP_ADDF(v, ctrl) v += __uint_as_float((unsigned)__builtin_amdgcn_update_dpp(0, (int)__float_as_uint(v), ctrl, 0xf, 0xf, true))
__device__ __forceinline__ float wave_sum_dpp(float v) {
    DPP_ADDF(v, 0xB1); DPP_ADDF(v, 0x4E); DPP_ADDF(v, 0x141); DPP_ADDF(v, 0x140);
    const float a = __uint_as_float((unsigned)__builtin_amdgcn_readlane((int)__float_as_uint(v), 0)), b = __uint_as_float((unsigned)__builtin_amdgcn_readlane((int)__float_as_uint(v), 16));
    const float c = __uint_as_float((unsigned)__builtin_amdgcn_readlane((int)__float_as_uint(v), 32)), d = __uint_as_float((unsigned)__builtin_amdgcn_readlane((int)__float_as_uint(v), 48));
    return (a + b) + (c + d);
}
__device__ __forceinline__ void phase1(const Params& p, LAS unsigned char* lds) {
    const int tid_ = fresh_tid(); const int lane = tid_ & 63, wid = tid_ >> 6;
    const int gw = blockIdx.x * NWAVES + wid, ngw = gridDim.x * NWAVES;
    const float* mod = (const float*)(p.ws + WS_MOD); const float* WF = (const float*)(p.ws + WS_WF);
    bf16_t* H = (bf16_t*)(p.ws + WS_H); float* LS = (float*)(p.ws + WS_LS);
    LAS float* wfl = (LAS float*)lds;
    for (int i = tid_; i < 8 * DM / 4; i += NTHREADS) *(LAS f32x4*)(wfl + 4 * i) = *(const f32x4*)(WF + 4 * i);
    __syncthreads();
    float g[16]; ld16(p.g_pre_mix, lane, g);
    const float bfg = (lane & 7) == 0 ? p.b_fgate[lane >> 3] : 0.f;
    for (int t0 = gw * 16; t0 < T; t0 += ngw * 16) {
        const int b = t0 / SEQ;
        float A[16], sh[16];
        { float sc[16]; ld16(mod + b * NMOD, lane, sh); ld16(mod + b * NMOD + DM, lane, sc);
#pragma unroll
          for (int i = 0; i < 16; ++i) A[i] = g[i] * (1.f + sc[i]); }
        float xn[16]; ld16(p.x + (size_t)t0 * DM, lane, xn);
#pragma unroll 1
        for (int r = 0; r < 16; ++r) {
            const int t = t0 + r;
            float xv[16];
#pragma unroll
            for (int i = 0; i < 16; ++i) xv[i] = xn[i];
            if (r + 1 < 16) ld16(p.x + (size_t)(t + 1) * DM, lane, xn);
            float ss = 0.f;
#pragma unroll
            for (int i = 0; i < 16; ++i) ss += xv[i] * xv[i];
            const float rstd = rsqrtf(wave_sum_dpp(ss) * (1.f / DM) + RMS_EPS);
            float h[16];
#pragma unroll
            for (int i = 0; i < 16; ++i) h[i] = xv[i] * rstd * A[i] + sh[i];
            st16_bf16(H + (size_t)t * DM, lane, h);
            float s[8];
#pragma unroll
            for (int hd = 0; hd < 8; ++hd) {
                const LAS float* wr = wfl + hd * DM;
                const f32x4 w0 = *(const LAS f32x4*)(wr + 8 * lane), w1 = *(const LAS f32x4*)(wr + 8 * lane + 4), w2 = *(const LAS f32x4*)(wr + 512 + 8 * lane), w3 = *(const LAS f32x4*)(wr + 512 + 8 * lane + 4);
                float a = 0.f;
#pragma unroll
                for (int i = 0; i < 4; ++i) a += h[i] * w0[i] + h[4 + i] * w1[i] + h[8 + i] * w2[i] + h[12 + i] * w3[i];
                s[hd] = a;
            }
            const bool b32 = (lane & 32) != 0, b16 = (lane & 16) != 0, b8 = (lane & 8) != 0;
            float r4[4], r2[2], v;
#pragma unroll
            for (int k = 0; k < 4; ++k) { const float mine = b32 ? s[k + 4] : s[k], send = b32 ? s[k] : s[k + 4]; r4[k] = mine + __shfl_xor(send, 32); }
#pragma unroll
            for (int k = 0; k < 2; ++k) { const float mine = b16 ? r4[k + 2] : r4[k], send = b16 ? r4[k] : r4[k + 2]; r2[k] = mine + __shfl_xor(send, 16); }
            { const float mine = b8 ? r2[1] : r2[0], send = b8 ? r2[0] : r2[1]; v = mine + __shfl_xor(send, 8); }
            v += __shfl_xor(v, 4); v += __shfl_xor(v, 2); v += __shfl_xor(v, 1);
            if ((lane & 7) == 0) { const float z = v + bfg;
                const float lsg = z >= 0.f ? -log1pf(__expf(-z)) : z - log1pf(__expf(z));
                LS[(size_t)t * 8 + (lane >> 3)] = lsg; }
        }
    }
    __syncthreads();
}

__device__ __forceinline__ void scan_kb(const Params& p, LAS unsigned char* lds) {
    const int first = (int)gridDim.x >= BATCH * 8 ? (int)gridDim.x - BATCH * 8 : 0;
    for (int sb = (int)blockIdx.x - first; sb >= 0 && sb < BATCH * 8; sb += (int)gridDim.x) {
        const int tid = fresh_tid(), lane = tid & 63, wid = tid >> 6, b = sb >> 3, hd = sb & 7;
        const float* LS = (const float*)(p.ws + WS_LS) + (size_t)b * SEQ * 8 + hd; float* KB = (float*)(p.ws + WS_KB) + (size_t)sb * SEQ;
        LAS double* wtot = (LAS double*)lds;
        double loc[16]; double s = 0.0;
#pragma unroll
        for (int i = 0; i < 16; ++i) { s += (double)LS[(size_t)(tid * 16 + i) * 8]; loc[i] = s; }
        double v = s;
#pragma unroll
        for (int o = 1; o < 64; o <<= 1) { const double u = __shfl_up(v, o); if (lane >= o) v += u; }
        __syncthreads();
        if (lane == 63) wtot[wid] = v;
        __syncthreads();
        double base = v - s;
        for (int w = 0; w < wid; ++w) base += wtot[w];
#pragma unroll
        for (int i = 0; i < 16; ++i) KB[tid * 16 + i] = (float)(-(base + loc[i]) * (double)LOG2E);
        __syncthreads();
    }
}

__device__ __forceinline__ void stage_kv_tile(LAS unsigned char* kimg, LAS unsigned char* vimg, const bf16_t* Kg, const bf16_t* Vg, long row0, long rowmin, int pitch, int wid, int lane) {
    long rk = row0 + lane; if (rk < rowmin) rk = rowmin;
    const bf16_t* ks = Kg + rk * pitch + wid * 8;
    __builtin_amdgcn_global_load_lds((const unsigned*)ks, (LAS unsigned*)(kimg + wid * 1024), 16, 0, 0);
    long rv = row0 + 16 * (wid & 3) + (lane >> 2); if (rv < rowmin) rv = rowmin;
    const bf16_t* vs = Vg + rv * pitch + (wid >> 2) * 32 + (lane & 3) * 8;
    __builtin_amdgcn_global_load_lds((const unsigned*)vs, (LAS unsigned*)(vimg + wid * 1024), 16, 0, 0);
}
__device__ __forceinline__ s16x4 vtr(const LAS unsigned char* ptr) {
    typedef short v4i16_t __attribute__((ext_vector_type(4)));
    return __builtin_bit_cast(s16x4, __builtin_amdgcn_ds_read_tr16_b64_v4i16((LAS v4i16_t*)ptr));
}
__device__ __forceinline__ void qk_tile(f32x16& p0, f32x16& p1, const LAS unsigned char* kimg, const bf16x8 (&qr)[4], int r32, int hi) {
    const LAS unsigned char* kb = kimg + hi * 1024 + r32 * 16;
    p0 = (f32x16){}; p1 = (f32x16){};
#pragma unroll
    for (int d0 = 0; d0 < 4; ++d0) {
        const bf16x8 b0 = *(const LAS bf16x8*)(kb + d0 * 2048), b1 = *(const LAS bf16x8*)(kb + d0 * 2048 + 512);
        p0 = __builtin_amdgcn_mfma_f32_32x32x16_bf16(b0, qr[d0], p0, 0, 0, 0);
        p1 = __builtin_amdgcn_mfma_f32_32x32x16_bf16(b1, qr[d0], p1, 0, 0, 0);
    }
}
__device__ __forceinline__ void softmax_pv(f32x16& p0, f32x16& p1, const LAS unsigned char* vimg, f32x16& o0, f32x16& o1, float& m, float& l, int lane, int hi) {
    float rm = p0[0];
#pragma unroll
    for (int r = 1; r < 16; ++r) rm = fmaxf(rm, p0[r]);
#pragma unroll
    for (int r = 0; r < 16; ++r) rm = fmaxf(rm, p1[r]);
    rm = fmaxf(rm, __shfl_xor(rm, 32));
    const float mn = fmaxf(m, rm);
    const float alpha = __builtin_amdgcn_exp2f(m - mn);
    m = mn;
    float ps = 0.f;
#pragma unroll
    for (int r = 0; r < 16; ++r) { p0[r] = __builtin_amdgcn_exp2f(p0[r] - mn); ps += p0[r]; }
#pragma unroll
    for (int r = 0; r < 16; ++r) { p1[r] = __builtin_amdgcn_exp2f(p1[r] - mn); ps += p1[r]; }
    l = l * alpha + ps;
    if (!__all(alpha == 1.0f)) {
#pragma unroll
        for (int r = 0; r < 16; ++r) { const float a = __shfl(alpha, crow(r, hi)); o0[r] *= a; o1[r] *= a; }
    }
    u32x4 pw[4];
    pw[0] = (u32x4){cvtpk(p0[0], p0[1]), cvtpk(p0[2], p0[3]), cvtpk(p0[4], p0[5]), cvtpk(p0[6], p0[7])};
    pw[1] = (u32x4){cvtpk(p0[8], p0[9]), cvtpk(p0[10], p0[11]), cvtpk(p0[12], p0[13]), cvtpk(p0[14], p0[15])};
    pw[2] = (u32x4){cvtpk(p1[0], p1[1]), cvtpk(p1[2], p1[3]), cvtpk(p1[4], p1[5]), cvtpk(p1[6], p1[7])};
    pw[3] = (u32x4){cvtpk(p1[8], p1[9]), cvtpk(p1[10], p1[11]), cvtpk(p1[12], p1[13]), cvtpk(p1[14], p1[15])};
    const LAS unsigned char* vb = vimg + ((lane >> 4) & 1) * 32 + (lane & 3) * 8 + (4 * hi + ((lane & 15) >> 2)) * 64;
#pragma unroll
    for (int ks = 0; ks < 4; ++ks) {
        const bf16x8 pa = __builtin_bit_cast(bf16x8, pw[ks]);
        { const s16x4 lo = vtr(vb + ks * 1024), hh = vtr(vb + ks * 1024 + 512);
          const bf16x8 vf = (bf16x8){lo[0], lo[1], lo[2], lo[3], hh[0], hh[1], hh[2], hh[3]};
          o0 = __builtin_amdgcn_mfma_f32_32x32x16_bf16(pa, vf, o0, 0, 0, 0); }
        { const s16x4 lo = vtr(vb + 4096 + ks * 1024), hh = vtr(vb + 4096 + ks * 1024 + 512);
          const bf16x8 vf = (bf16x8){lo[0], lo[1], lo[2], lo[3], hh[0], hh[1], hh[2], hh[3]};
          o1 = __builtin_amdgcn_mfma_f32_32x32x16_bf16(pa, vf, o1, 0, 0, 0); }
    }
}
__device__ __forceinline__ void store_o(bf16_t* Obase  , int pitch, const f32x16& o0, const f32x16& o1, float linv, int r32, int hi) {
#pragma unroll
    for (int r = 0; r < 16; ++r) { const int q = crow(r, hi); const float li = __shfl(linv, q);
        bf16_t* rp = Obase + (size_t)q * pitch;
        rp[r32] = (bf16_t)(cvtpk(o0[r] * li, 0.f) & 0xffffu); rp[32 + r32] = (bf16_t)(cvtpk(o1[r] * li, 0.f) & 0xffffu); }
}

constexpr float FOX_THR = 30.f;
__device__ __forceinline__ void glds16(const void* gsrc, unsigned lds_dst) {
    unsigned keep;
    asm volatile("s_mov_b32 %0, m0\n\ts_mov_b32 m0, %2\n\ts_nop 0\n\tglobal_load_lds_dwordx4 %1, off\n\ts_mov_b32 m0, %0" : "=&s"(keep) : "v"(gsrc), "s"(lds_dst) : "memory");
}
__device__ __forceinline__ unsigned f2ord(float f) { const unsigned b = __float_as_uint(f); return (b & 0x80000000u) ? ~b : (b | 0x80000000u); }
__device__ __forceinline__ float ord2f(unsigned u) { return __uint_as_float((u & 0x80000000u) ? (u & 0x7fffffffu) : ~u); }
__device__ __forceinline__ void fox_prepass(const Params& p) {
    const int tid = fresh_tid(), lane = tid & 63, gw = blockIdx.x * NWAVES + (tid >> 6), ngw = gridDim.x * NWAVES;
    const bf16_t* PROJ = (const bf16_t*)(p.ws + WS_PROJ); float* KT = (float*)(p.ws + WS_KT);
    for (int it = gw; it < 32 * 128; it += ngw) {
        const int bh = it >> 7, j = it & 127, b = bh >> 3, h = bh & 7;
        const bf16_t* kr = PROJ + (size_t)((long)b * SEQ + 64 * j + lane) * NPROJ + 512 + h * 64;
        float ss = 0.f;
#pragma unroll
        for (int c = 0; c < 8; ++c) { const u32x4 w = *(const u32x4*)(kr + 8 * c);
            ss += bflo(w.x) * bflo(w.x) + bfhi(w.x) * bfhi(w.x) + bflo(w.y) * bflo(w.y) + bfhi(w.y) * bfhi(w.y) + bflo(w.z) * bflo(w.z) + bfhi(w.z) * bfhi(w.z) + bflo(w.w) * bflo(w.w) + bfhi(w.w) * bfhi(w.w); }
#pragma unroll
        for (int o = 1; o < 64; o <<= 1) ss = fmaxf(ss, __shfl_xor(ss, o));
        if (lane == 0) KT[it] = ss;
    }
}
constexpr int FOX_BUF = 16384, FOX_NBUF = 4, FOX_KB_OFF = FOX_NBUF * FOX_BUF, FOX_CTL_OFF = FOX_KB_OFF + 32768;
#define FOX_WAIT_BAR(N) asm volatile("s_waitcnt vmcnt(" #N ")\n\ts_barrier" ::: "memory")
__device__ __forceinline__ void fox_stage(unsigned ldsbase, int slot, const bf16_t* Kg, const bf16_t* Vg, long row0, int wid, int lane) {
    const bf16_t* ks = Kg + (row0 + lane) * NPROJ + wid * 8;
    const bf16_t* vs = Vg + (row0 + 16 * (wid & 3) + (lane >> 2)) * NPROJ + (wid >> 2) * 32 + (lane & 3) * 8;
    const unsigned dst = (unsigned)__builtin_amdgcn_readfirstlane((int)(ldsbase + (unsigned)slot * FOX_BUF + (unsigned)wid * 1024u));
    glds16(ks, dst); glds16(vs, dst + 8192u);
}
__device__ __forceinline__ void fox_unit(const Params& p, LAS unsigned char* lds, int b, int h, int qb) {
    const int tid = fresh_tid(), lane = tid & 63, wid = __builtin_amdgcn_readfirstlane(tid >> 6), r32 = lane & 31, hi = lane >> 5;
    const bf16_t* PROJ = (const bf16_t*)(p.ws + WS_PROJ);
    bf16_t* ATT = (bf16_t*)(p.ws + WS_ATT);
    const float* KB = (const float*)(p.ws + WS_KB) + (size_t)(b * 8 + h) * SEQ;
    const float* KT = (const float*)(p.ws + WS_KT) + (b * 8 + h) * 128;
    const long rowb = (long)b * SEQ; const int q0 = qb * 256;
    const bf16_t* Kg = PROJ + 512 + h * 64; const bf16_t* Vg = PROJ + 1024 + h * 64;
    LAS float* kbl = (LAS float*)(lds + FOX_KB_OFF); LAS unsigned* ctl = (LAS unsigned*)(lds + FOX_CTL_OFF);
    const unsigned ldsbase = (unsigned)(uintptr_t)lds;
    const int qw = q0 + 32 * wid;
    const int NT = (q0 + 256) / 64;
    bf16x8 qr[4]; float qn2 = 0.f, xs = 0.f;
#pragma unroll
    for (int d0 = 0; d0 < 4; ++d0) {
        qr[d0] = *(const bf16x8*)(PROJ + (size_t)(rowb + qw + r32) * NPROJ + h * 64 + d0 * 16 + hi * 8);
        const bf16x8 kk = *(const bf16x8*)(PROJ + (size_t)(rowb + qw + r32) * NPROJ + 512 + h * 64 + d0 * 16 + hi * 8);
#pragma unroll
        for (int j = 0; j < 8; ++j) { const float v = __uint_as_float(((unsigned)(unsigned short)qr[d0][j]) << 16), kv = __uint_as_float(((unsigned)(unsigned short)kk[j]) << 16); qn2 += v * v; xs += v * kv; }
    }
    qn2 += __shfl_xor(qn2, 32); xs += __shfl_xor(xs, 32);
    const float kbq = KB[qw + r32];
    float kt_ = 0.f, kbe_ = 0.f;
    if (tid < NT) { kt_ = KT[tid]; kbe_ = KB[64 * tid + 63]; }
    __syncthreads();
    if (tid == 0) { ctl[0] = 0u; ctl[1] = (unsigned)(NT - 4); ctl[2] = 0u; ctl[3] = 0xffffffffu; }
    __syncthreads();
    { float qm = qn2, sm = xs + kbq;
#pragma unroll
      for (int o = 1; o < 32; o <<= 1) { qm = fmaxf(qm, __shfl_xor(qm, o)); sm = fminf(sm, __shfl_xor(sm, o)); }
      if (lane == 0) { atomicMax((unsigned*)&ctl[0], __float_as_uint(qm)); atomicMin((unsigned*)&ctl[3], f2ord(sm)); } }
    __syncthreads();
    const float qmax2 = __uint_as_float(ctl[0]);
    if (tid < NT - 4) {
        const float smin = ord2f(ctl[3]);
        const float ub = sqrtf(qmax2 * kt_) * 1.0001f + kbe_;
        if (!(ub + FOX_THR <= smin - 1e-3f * fabsf(smin))) atomicMin((unsigned*)&ctl[1], (unsigned)tid);
    }
    __syncthreads();
    const int jstart = (int)ctl[1];
    __builtin_amdgcn_s_waitcnt(0);
    fox_stage(ldsbase, 0, Kg, Vg, rowb + 64 * jstart, wid, lane);
    if (jstart + 1 < NT) fox_stage(ldsbase, 1, Kg, Vg, rowb + 64 * (jstart + 1), wid, lane);
    if (jstart + 2 < NT) fox_stage(ldsbase, 2, Kg, Vg, rowb + 64 * (jstart + 2), wid, lane);
    if (tid >= jstart && tid < NT) atomicMax((unsigned*)&ctl[2], __float_as_uint(kt_));
    for (int i = 64 * jstart + tid; i < 64 * NT; i += NTHREADS) kbl[i - 64 * jstart] = KB[i];
    __syncthreads();
    const float kmaxu = sqrtf(__uint_as_float(ctl[2]));
    const float ref = sqrtf(qn2) * kmaxu * 1.0001f + kbq;
    f32x16 o0 = (f32x16){}, o1 = (f32x16){}; float l = 0.f;
    for (int jt = jstart; jt < NT; ++jt) {
        if (jt + 2 < NT) FOX_WAIT_BAR(4); else if (jt + 1 < NT) FOX_WAIT_BAR(2); else FOX_WAIT_BAR(0);
        if (jt + 3 < NT) fox_stage(ldsbase, (jt + 3 - jstart) & 3, Kg, Vg, rowb + 64 * (jt + 3), wid, lane);
        LAS unsigned char* buf = lds + ((jt - jstart) & 3) * FOX_BUF;
        if (64 * jt <= qw + 31) {
            const LAS float* kbt = kbl + 64 * (jt - jstart);
            f32x16 p0, p1;
#pragma unroll
            for (int g = 0; g < 4; ++g) {
                const f32x4 k0 = *(const LAS f32x4*)(kbt + 8 * g + 4 * hi), k1 = *(const LAS f32x4*)(kbt + 32 + 8 * g + 4 * hi);
#pragma unroll
                for (int i = 0; i < 4; ++i) { p0[4 * g + i] = k0[i] - ref; p1[4 * g + i] = k1[i] - ref; }
            }
            { const LAS unsigned char* kb_ = buf + hi * 1024 + r32 * 16;
#pragma unroll
              for (int d0 = 0; d0 < 4; ++d0) {
                  const bf16x8 b0 = *(const LAS bf16x8*)(kb_ + d0 * 2048), b1 = *(const LAS bf16x8*)(kb_ + d0 * 2048 + 512);
                  p0 = __builtin_amdgcn_mfma_f32_32x32x16_bf16(b0, qr[d0], p0, 0, 0, 0);
                  p1 = __builtin_amdgcn_mfma_f32_32x32x16_bf16(b1, qr[d0], p1, 0, 0, 0);
              } }
            float ps = 0.f;
            if (64 * jt + 63 > qw) {
                const int tq = qw + r32;
#pragma unroll
                for (int r = 0; r < 16; ++r) { const int s_ = 64 * jt + crow(r, hi);
                    p0[r] = (s_ > tq) ? 0.f : __builtin_amdgcn_exp2f(p0[r]); p1[r] = (s_ + 32 > tq) ? 0.f : __builtin_amdgcn_exp2f(p1[r]); ps += p0[r] + p1[r]; }
            } else {
#pragma unroll
                for (int r = 0; r < 16; ++r) { p0[r] = __builtin_amdgcn_exp2f(p0[r]); p1[r] = __builtin_amdgcn_exp2f(p1[r]); ps += p0[r] + p1[r]; }
            }
            l += ps;
            u32x4 pw[4];
            pw[0] = (u32x4){cvtpk(p0[0], p0[1]), cvtpk(p0[2], p0[3]), cvtpk(p0[4], p0[5]), cvtpk(p0[6], p0[7])};
            pw[1] = (u32x4){cvtpk(p0[8], p0[9]), cvtpk(p0[10], p0[11]), cvtpk(p0[12], p0[13]), cvtpk(p0[14], p0[15])};
            pw[2] = (u32x4){cvtpk(p1[0], p1[1]), cvtpk(p1[2], p1[3]), cvtpk(p1[4], p1[5]), cvtpk(p1[6], p1[7])};
            pw[3] = (u32x4){cvtpk(p1[8], p1[9]), cvtpk(p1[10], p1[11]), cvtpk(p1[12], p1[13]), cvtpk(p1[14], p1[15])};
            const LAS unsigned char* vb = buf + 8192 + ((lane >> 4) & 1) * 32 + (lane & 3) * 8 + (4 * hi + ((lane & 15) >> 2)) * 64;
#pragma unroll
            for (int ks = 0; ks < 4; ++ks) {
                const bf16x8 pa = __builtin_bit_cast(bf16x8, pw[ks]);
                { const s16x4 lo = vtr(vb + ks * 1024), hh = vtr(vb + ks * 1024 + 512);
                  const bf16x8 vf = (bf16x8){lo[0], lo[1], lo[2], lo[3], hh[0], hh[1], hh[2], hh[3]};
                  o0 = __builtin_amdgcn_mfma_f32_32x32x16_bf16(pa, vf, o0, 0, 0, 0); }
                { const s16x4 lo = vtr(vb + 4096 + ks * 1024), hh = vtr(vb + 4096 + ks * 1024 + 512);
                  const bf16x8 vf = (bf16x8){lo[0], lo[1], lo[2], lo[3], hh[0], hh[1], hh[2], hh[3]};
                  o1 = __builtin_amdgcn_mfma_f32_32x32x16_bf16(pa, vf, o1, 0, 0, 0); }
            }
        }
    }
    const float lt = l + __shfl_xor(l, 32);
    const float linv = 1.f / lt;
    __syncthreads();
    {
        LAS bf16_t* stg = (LAS bf16_t*)(lds + wid * 4096);
#pragma unroll
        for (int r = 0; r < 16; ++r) { const int q = crow(r, hi); const float li = __shfl(linv, q);
            stg[q * 64 + r32] = (bf16_t)(cvtpk(o0[r] * li, 0.f) & 0xffffu); stg[q * 64 + 32 + r32] = (bf16_t)(cvtpk(o1[r] * li, 0.f) & 0xffffu); }
        bf16_t* Ow = ATT + (size_t)(rowb + qw) * DM + h * 64;
#pragma unroll
        for (int i = 0; i < 4; ++i) { const int row = i * 8 + (lane >> 3), ch = lane & 7; const u32x4 v = *(const LAS u32x4*)(stg + row * 64 + ch * 8); *(u32x4*)(Ow + (size_t)row * DM + ch * 8) = v; }
    }
}
__device__ __forceinline__ void phase_fox(const Params& p, LAS unsigned char* lds) {
    if ((gridDim.x & 7) == 0) {
        unsigned* qw_ = (unsigned*)(p.ws + WS_BAR) + 16 * (blockIdx.x & 7);
        LAS int* uq = (LAS int*)(lds + FOX_CTL_OFF + 64);
        const int x = blockIdx.x & 7;
        for (;;) {
            __syncthreads();
            if (threadIdx.x == 0) *uq = (int)atomicAdd(qw_, 1u);
            __syncthreads();
            const int u = *uq;
            if (u >= 128) break;
            const int i = u & 3;
            fox_unit(p, lds, i, (x - i) & 7, 31 - (u >> 2));
        }
    } else {
        for (int u = blockIdx.x; u < 1024; u += gridDim.x) fox_unit(p, lds, (u & 31) >> 3, u & 7, 31 - (u >> 5));
    }
}

__device__ __forceinline__ void swa_unit(const Params& p, LAS unsigned char* lds, int b, int kvh, int qblk) {
    const int tid = fresh_tid(), lane = tid & 63, wid = __builtin_amdgcn_readfirstlane(tid >> 6), r32 = lane & 31, hi = lane >> 5;
    const bf16_t* PROJ = (const bf16_t*)(p.ws + WS_PROJ);
    bf16_t* ATT = (bf16_t*)(p.ws + WS_ATT);
    const long rowb = (long)b * SEQ; const int q0 = qblk * 128;
    const bf16_t* Kg = PROJ + 2048 + kvh * 64; const bf16_t* Vg = PROJ + 2176 + kvh * 64;
    __syncthreads();
#pragma unroll
    for (int j = 0; j < 4; ++j) stage_kv_tile(lds + j * 16384, lds + j * 16384 + 8192, Kg, Vg, rowb + q0 - 128 + 64 * j, rowb, NPROJ, wid, lane);
    __syncthreads();
#pragma unroll 1
    for (int i = 0; i < 2; ++i) {
        const int task = wid * 2 + i, g = task >> 2, sub = task & 3, hq = kvh * 4 + g;
        const int qw = q0 + 32 * sub;
        const float slope = exp2f(-(float)(hq + 1)) * LOG2E;
        bf16x8 qr[4];
#pragma unroll
        for (int d0 = 0; d0 < 4; ++d0) qr[d0] = *(const bf16x8*)(PROJ + (size_t)(rowb + qw + r32) * NPROJ + 1536 + hq * 64 + d0 * 16 + hi * 8);
        f32x16 o0 = (f32x16){}, o1 = (f32x16){}; float m = NEGBIG, l = 0.f;
        const int j0 = (32 * sub + 1) >> 6, j1 = (32 * sub + 159) >> 6;
        for (int j = j0; j <= j1; ++j) {
            f32x16 p0, p1; qk_tile(p0, p1, lds + j * 16384, qr, r32, hi);
            const int tq = 128 + 32 * sub + r32;
#pragma unroll
            for (int r = 0; r < 16; ++r) {
                const int s0 = 64 * j + crow(r, hi), s1 = s0 + 32;
                const int d0 = tq - s0, d1 = tq - s1;
                const bool v0 = (d0 >= 0) && (d0 < 128) && (q0 - 128 + s0 >= 0), v1 = (d1 >= 0) && (d1 < 128) && (q0 - 128 + s1 >= 0);
                p0[r] = v0 ? p0[r] - slope * (float)d0 : NEGBIG; p1[r] = v1 ? p1[r] - slope * (float)d1 : NEGBIG;
            }
            softmax_pv(p0, p1, lds + j * 16384 + 8192, o0, o1, m, l, lane, hi);
        }
        float lt = l + __shfl_xor(l, 32);
        lt += exp2f(p.swa_sinks[hq] * LOG2E - m);
        store_o(ATT + (size_t)(rowb + qw) * DM + 512 + hq * 64, DM, o0, o1, 1.f / lt, r32, hi);
    }
}
__device__ __forceinline__ void phase_swa(const Params& p, LAS unsigned char* lds) {
    for (int u = blockIdx.x; u < BATCH * 2 * 64; u += gridDim.x) { const int bk = u & 7; swa_unit(p, lds, bk >> 1, bk & 1, u >> 3); }
}

__device__ __forceinline__ void phase6(const Params& p) {
    const int tid_ = fresh_tid(); const int lane = tid_ & 63, wid = tid_ >> 6;
    const int gw = blockIdx.x * NWAVES + wid, ngw = gridDim.x * NWAVES;
    const float* mod = (const float*)(p.ws + WS_MOD);
    const bf16_t* Y1 = (const bf16_t*)(p.ws + WS_PROJ); bf16_t* H = (bf16_t*)(p.ws + WS_H);
    float* X1 = (float*)(p.ws + WS_X1); float* HMAX = (float*)(p.ws + WS_HMAX);
    float gpm[16], gpf[16]; ld16(p.g_post_mix, lane, gpm); ld16(p.g_pre_ffn, lane, gpf);
    for (int t0 = gw * 16; t0 < T; t0 += ngw * 16) {
        const int b = t0 / SEQ;
        float G1[16], A2[16], sh[16];
        { float gt[16], sc[16]; ld16(mod + b * NMOD + 2 * DM, lane, gt); ld16(mod + b * NMOD + 3 * DM, lane, sh); ld16(mod + b * NMOD + 4 * DM, lane, sc);
#pragma unroll
          for (int i = 0; i < 16; ++i) { G1[i] = gt[i] * gpm[i]; A2[i] = gpf[i] * (1.f + sc[i]); } }
        float yn[16], xn[16]; ld16_bf16(Y1 + (size_t)t0 * DM, lane, yn); ld16(p.x + (size_t)t0 * DM, lane, xn);
#pragma unroll 1
        for (int r = 0; r < 16; ++r) {
            const int t = t0 + r;
            float y[16], xv[16];
#pragma unroll
            for (int i = 0; i < 16; ++i) { y[i] = yn[i]; xv[i] = xn[i]; }
            if (r + 1 < 16) { ld16_bf16(Y1 + (size_t)(t + 1) * DM, lane, yn); ld16(p.x + (size_t)(t + 1) * DM, lane, xn); }
            float ss = 0.f;
#pragma unroll
            for (int i = 0; i < 16; ++i) ss += y[i] * y[i];
            const float rstd = rsqrtf(wave_sum_dpp(ss) * (1.f / DM) + RMS_EPS);
            float x1[16]; float s2 = 0.f;
#pragma unroll
            for (int i = 0; i < 16; ++i) { x1[i] = xv[i] + G1[i] * (y[i] * rstd); s2 += x1[i] * x1[i]; }
            st16_bf16((bf16_t*)(p.ws + WS_X1) + (size_t)t * DM, lane, x1);
            const float rstd2 = rsqrtf(wave_sum_dpp(s2) * (1.f / DM) + RMS_EPS);
            float h[16]; float hm = 0.f;
#pragma unroll
            for (int i = 0; i < 16; ++i) { h[i] = x1[i] * rstd2 * A2[i] + sh[i]; hm = fmaxf(hm, fabsf(__uint_as_float(cvtpk(h[i], 0.f) << 16))); }
            st16_bf16(H + (size_t)t * DM, lane, h);
#pragma unroll
            for (int o = 1; o < 64; o <<= 1) hm = fmaxf(hm, __shfl_xor(hm, o));
            if (lane == 0) HMAX[t] = hm;
        }
    }
}

template <int N> __device__ __forceinline__ void bitonic_sort_desc(float (&v)[N]) {
#pragma unroll
    for (int k = 2; k <= N; k <<= 1)
#pragma unroll
        for (int j = k >> 1; j > 0; j >>= 1)
#pragma unroll
            for (int i = 0; i < N; ++i) { const int x = i ^ j; if (x > i) { const bool up = ((i & k) == 0); const float a = v[i], b = v[x]; const float mx = vmaxf(a, b), mn = vminf(a, b); v[i] = up ? mx : mn; v[x] = up ? mn : mx; } }
}
__device__ __forceinline__ void bitonic_merge16_desc(float (&v)[16]) {
#pragma unroll
    for (int j = 8; j > 0; j >>= 1)
#pragma unroll
        for (int i = 0; i < 16; ++i) { const int x = i ^ j; if (x > i) { const float a = v[i], b = v[x]; v[i] = vmaxf(a, b); v[x] = vminf(a, b); } }
}
__device__ __forceinline__ void merge_partner(float (&a)[16], int xm) {
    float c[16];
#pragma unroll
    for (int i = 0; i < 16; ++i) c[i] = vmaxf(a[i], __shfl_xor(a[15 - i], xm));
    bitonic_merge16_desc(c);
#pragma unroll
    for (int i = 0; i < 16; ++i) a[i] = c[i];
}
__device__ __forceinline__ unsigned sel4(unsigned w0, unsigned w1, unsigned w2, unsigned w3, unsigned a) {
    const unsigned lo = (a & 4u) ? w1 : w0, hi2 = (a & 4u) ? w3 : w2; const unsigned w = (a & 8u) ? hi2 : lo; return (w >> (8u * (a & 3u))) & 0x7fu;
}
__device__ __forceinline__ void p8_stage(LAS unsigned char* buf, const bf16_t* SK, int g, int wid, int lane) {
#pragma unroll
    for (int j = 0; j < 4; ++j) { const int pc = wid * 4 + j, row = 4 * pc + (lane >> 4), pos = lane & 15;
        const unsigned char* src = (const unsigned char*)SK + (size_t)g * 32768 + row * 256 + ((pos ^ (row & 15)) << 4);
        __builtin_amdgcn_global_load_lds((const unsigned*)src, (LAS unsigned*)(buf + pc * 1024), 16, 0, 0); }
}
__device__ __forceinline__ void phase8_block(const Params& p, LAS unsigned char* lds, int t0, int wid, int lane) {
    const int fr = lane & 15, fq = lane >> 4;
    const bf16_t* Q2 = (const bf16_t*)(p.ws + WS_PROJ); const bf16_t* SK = (const bf16_t*)(p.ws + WS_SK);
    int* EIDX = (int*)(p.ws + WS_EIDX); float* GATE = (float*)(p.ws + WS_GATE);
    float keep[2][2][16];
#pragma unroll
    for (int a_ = 0; a_ < 2; ++a_)
#pragma unroll
        for (int b_ = 0; b_ < 2; ++b_)
#pragma unroll
            for (int i_ = 0; i_ < 16; ++i_) keep[a_][b_][i_] = 0.f;
    const bf16_t* qrow = Q2 + (size_t)(t0 + fr) * 2048 + 8 * fq;
    bf16x8 bqn[4];
#pragma unroll
    for (int s = 0; s < 4; ++s) bqn[s] = *(const bf16x8*)(qrow + 32 * s);
    __syncthreads();
    p8_stage(lds, SK, 0, wid, lane);
#pragma unroll 1
    for (int hp = 0; hp < 4; ++hp) {
#pragma unroll
        for (int hh = 0; hh < 2; ++hh) {
#pragma unroll
            for (int pp = 0; pp < 2; ++pp) {
                const int grp = (2 * hp + hh) * 2 + pp;
                bf16x8 bq[4];
#pragma unroll
                for (int s = 0; s < 4; ++s) bq[s] = bqn[s];
                __syncthreads();
                if (grp + 1 < 16) { p8_stage(lds + ((grp + 1) & 1) * 32768, SK, grp + 1, wid, lane);
#pragma unroll
                    for (int s = 0; s < 4; ++s) bqn[s] = *(const bf16x8*)(qrow + (grp + 1) * 128 + 32 * s); }
                const LAS unsigned char* kb_ = lds + (grp & 1) * 32768 + fr * 256;
                float v[32];
#pragma unroll
                for (int mt = 0; mt < 8; ++mt) {
                    f32x4 acc = (f32x4){0.f, 0.f, 0.f, 0.f};
#pragma unroll
                    for (int s = 0; s < 4; ++s) { const bf16x8 a = *(const LAS bf16x8*)(kb_ + mt * 4096 + (((4 * s + fq) ^ fr) << 4)); acc = __builtin_amdgcn_mfma_f32_16x16x32_bf16(a, bq[s], acc, 0, 0, 0); }
                    unsigned f4 = 4u * (unsigned)fq; asm volatile("" : "+v"(f4));
#pragma unroll
                    for (int i = 0; i < 4; ++i) v[mt * 4 + i] = __uint_as_float(((__float_as_uint(acc[i]) & ~127u) | f4) | (unsigned)(16 * mt + i));
                }
                bitonic_sort_desc<32>(v);
                float a16[16];
#pragma unroll
                for (int i = 0; i < 16; ++i) a16[i] = v[i];
                merge_partner(a16, 16); merge_partner(a16, 32);
                const bool mine = (fq == hp);
#pragma unroll
                for (int i = 0; i < 16; ++i) keep[hh][pp][i] = mine ? a16[i] : keep[hh][pp][i];
            }
        }
    }
#pragma unroll
    for (int hh = 0; hh < 2; ++hh) {
        const float (&L1)[16] = keep[hh][0]; const float (&L2)[16] = keep[hh][1];
#define P8_CAND(a, b) __uint_as_float((__float_as_uint(L1[a] + L2[b]) & ~255u) | (unsigned)((a) * 16 + (b)))
        float R[16], Bl[16], Cl[16];
#pragma unroll
        for (int bb = 0; bb < 16; ++bb) R[bb] = P8_CAND(0, bb);
#pragma unroll
        for (int i = 0; i < 8; ++i) { Bl[i] = P8_CAND(1, i); Bl[8 + i] = P8_CAND(15 - i, 0); }
        bitonic_merge16_desc(Bl);
        Cl[0] = P8_CAND(2, 0); Cl[1] = P8_CAND(2, 1); Cl[2] = P8_CAND(2, 2); Cl[3] = P8_CAND(2, 3); Cl[4] = P8_CAND(2, 4);
        Cl[5] = P8_CAND(3, 0); Cl[6] = P8_CAND(3, 1); Cl[7] = P8_CAND(3, 2); Cl[8] = P8_CAND(3, 3);
        Cl[9] = P8_CAND(4, 0); Cl[10] = P8_CAND(4, 1); Cl[11] = P8_CAND(4, 2);
        Cl[12] = P8_CAND(5, 0); Cl[13] = P8_CAND(5, 1); Cl[14] = P8_CAND(6, 0); Cl[15] = P8_CAND(6, 1);
        bitonic_sort_desc<16>(Cl);
        { float c[16];
#pragma unroll
          for (int i = 0; i < 16; ++i) c[i] = vmaxf(R[i], Bl[15 - i]);
          bitonic_merge16_desc(c);
#pragma unroll
          for (int i = 0; i < 16; ++i) c[i] = vmaxf(c[i], Cl[15 - i]);
          bitonic_merge16_desc(c);
          c[15] = vmaxf(c[15], P8_CAND(7, 0)); c[14] = vmaxf(c[14], P8_CAND(7, 1));
          bitonic_merge16_desc(c);
#pragma unroll
          for (int i = 0; i < 16; ++i) R[i] = c[i]; }
#undef P8_CAND
        unsigned pk1[4], pk2[4];
#pragma unroll
        for (int w = 0; w < 4; ++w) {
            pk1[w] = (__float_as_uint(L1[4 * w]) & 127u) | ((__float_as_uint(L1[4 * w + 1]) & 127u) << 8) | ((__float_as_uint(L1[4 * w + 2]) & 127u) << 16) | ((__float_as_uint(L1[4 * w + 3]) & 127u) << 24);
            pk2[w] = (__float_as_uint(L2[4 * w]) & 127u) | ((__float_as_uint(L2[4 * w + 1]) & 127u) << 8) | ((__float_as_uint(L2[4 * w + 2]) & 127u) << 16) | ((__float_as_uint(L2[4 * w + 3]) & 127u) << 24);
        }
        float mx = R[0];
#pragma unroll
        for (int i = 1; i < 16; ++i) mx = fmaxf(mx, R[i]);
        float e[16]; float se = 0.f;
#pragma unroll
        for (int i = 0; i < 16; ++i) { e[i] = __expf(R[i] - mx); se += e[i]; }
        const float inv = 1.f / se;
        int ex[16];
#pragma unroll
        for (int i = 0; i < 16; ++i) { const unsigned bits = __float_as_uint(R[i]); const unsigned a = (bits >> 4) & 15u, bb = bits & 15u;
            ex[i] = (int)(sel4(pk1[0], pk1[1], pk1[2], pk1[3], a) * 128u + sel4(pk2[0], pk2[1], pk2[2], pk2[3], bb)); e[i] *= inv; }
        const int head = 2 * fq + hh;
        int* ep = EIDX + (size_t)(t0 + fr) * 128 + head * 16; float* gp = GATE + (size_t)(t0 + fr) * 128 + head * 16;
#pragma unroll
        for (int i = 0; i < 16; i += 4) {
            int pk_[4];
#pragma unroll
            for (int q = 0; q < 4; ++q) pk_[q] = (int)((unsigned)ex[i + q] | ((cvtpk(e[i + q], 0.f) & 0xffffu) << 16));
            *(int4*)(ep + i) = make_int4(pk_[0], pk_[1], pk_[2], pk_[3]); }
        (void)gp;
    }
}

__device__ __forceinline__ float gelu_tanh(float x) {
    const float z = 0.7978845608028654f * (x + 0.044715f * x * x * x);
    const float e = __expf(2.f * z); const float th = 1.f - 2.f * __builtin_amdgcn_rcpf(e + 1.f);
    return 0.5f * x * (1.f + th);
}
constexpr int P9_LIST = 0, P9_ACT = 4096, P9_STAGE = 6144, P9_RING = 7168  , P9_VRING = 4096  , P9_WAVE_LDS = 20480, P9_NBATCH = 64, P9_NENT = 1024;
typedef long i64_t;
__device__ __forceinline__ unsigned pk4_fp8(float a, float b, float c, float d) { int t_ = __builtin_amdgcn_cvt_pk_fp8_f32(a, b, 0, false); t_ = __builtin_amdgcn_cvt_pk_fp8_f32(c, d, t_, true); return (unsigned)t_; }

__device__ __forceinline__ void p9_dma_third(const unsigned char* const (&rowp)[4]  , unsigned ringaddr, int t, unsigned buf) {
#pragma unroll
    for (int j = 0; j < 4; ++j) glds16(rowp[j] + 256 * t, (unsigned)__builtin_amdgcn_readfirstlane((int)(ringaddr + buf * 4096u + (unsigned)j * 1024u)));
}
__device__ __forceinline__ void p9_rowptrs(const unsigned char* (&rowp)[4], const LAS unsigned* list, const unsigned char* U6, int batch, int lane) {
#pragma unroll
    for (int j = 0; j < 4; ++j) { const int row = 4 * j + (lane >> 4); const unsigned ent = list[batch * 16 + row];
        rowp[j] = U6 + (size_t)(ent & 0x3fffu) * 512 + 16 * ((lane & 15) ^ row); }
}
typedef int i32x8 __attribute__((ext_vector_type(8)));
template <int M> __device__ __forceinline__ void p9_mma_fp4(f32x4& acc, const LAS unsigned char* ringp, const i32x8 (&B)[8], unsigned hb0, int fr, int fq) {
    const u32x4 g = *(const LAS u32x4*)(ringp + (((hb0 + (unsigned)(M >> 2)) & 3u) << 12) + fr * 256 + ((((unsigned)(4 * (M & 3) + fq)) ^ (unsigned)fr) << 4));
    const i32x8 a = {(int)g.x, (int)g.y, (int)g.z, (int)g.w, 0, 0, 0, 0};
    acc = __builtin_amdgcn_mfma_scale_f32_16x16x128_f8f6f4(a, B[M], acc, 4  , 0  , 0, 0x7f7f7f7f, 0, 0x7f7f7f7f);
}
__device__ __forceinline__ void p9_rowptrs_q(const unsigned char* (&rowp)[2], const LAS unsigned* list, const unsigned char* U4, int batch, int lane) {
#pragma unroll
    for (int j = 0; j < 2; ++j) { const int row = 8 * j + (lane >> 3); const unsigned ent = list[batch * 16 + row];
        rowp[j] = U4 + (size_t)(ent & 0x3fffu) * 512 + 16 * ((lane & 7) ^ ((row >> 1) & 7)); }
}
__device__ __forceinline__ void p9_dma_quarter(const unsigned char* const (&rowp)[2], int q, unsigned bufaddr  ) {
#pragma unroll
    for (int j = 0; j < 2; ++j) glds16(rowp[j] + 128 * q, (unsigned)__builtin_amdgcn_readfirstlane((int)(bufaddr + (unsigned)j * 1024u)));
}
template <int M> __device__ __forceinline__ void p9_mma_q(f32x4& acc, const LAS unsigned char* bufp  , unsigned lofs  , const i32x8 (&B)[8]) {
    const u32x4 g = *(const LAS u32x4*)(bufp + lofs);
    const i32x8 a = {(int)g.x, (int)g.y, (int)g.z, (int)g.w, 0, 0, 0, 0};
    acc = __builtin_amdgcn_mfma_scale_f32_16x16x128_f8f6f4(a, B[M], acc, 4  , 0  , 0, 0x7f7f7f7f, 0, 0x7f7f7f7f);
}
__device__ __forceinline__ void p9_extract(const f32x4& acc, const LAS unsigned* list, LAS float* stage, LAS bf16_t* actl, int n0, int fr, int fq) {
    *(LAS f32x4*)(stage + fr * 16 + 4 * fq) = acc;
    const unsigned ent = list[n0 + fr]; const unsigned s_ = (ent >> 14) & 7u, idx = (ent >> 17) & 127u;
    const float val = stage[(2 * s_) * 16 + fr];
    if (fq == 0) actl[s_ * 128 + idx] = (bf16_t)(cvtpk(val, 0.f) & 0xffffu);
}

__device__ __forceinline__ void phase9_pass(const Params& p, LAS unsigned char* wl  , int tk0  , int lane) {
    const bf16_t* H = (const bf16_t*)(p.ws + WS_H);
    const unsigned char* U8 = p.ws + WS_U8; const unsigned char* V8 = p.ws + WS_V8;
    const float* SU = (const float*)(p.ws + WS_SU); const float* SV = (const float*)(p.ws + WS_SV);
    const int* EIDX = (const int*)(p.ws + WS_EIDX); const float* GATE = (const float*)(p.ws + WS_GATE);
    const float* HMAX = (const float*)(p.ws + WS_HMAX);
    const float* mod = (const float*)(p.ws + WS_MOD);
    LAS unsigned* list = (LAS unsigned*)(wl + P9_LIST);
    LAS bf16_t* actl = (LAS bf16_t*)(wl + P9_ACT);
    LAS float* stage = (LAS float*)(wl + P9_STAGE);
    LAS unsigned char* ringp = wl + P9_RING;
    LAS unsigned* cnt = (LAS unsigned*)ringp;
    LAS unsigned* off = cnt + 64;
    const int fr = lane & 15, fq = lane >> 4;
    cnt[lane] = 0u;
    unsigned offreg;
    {
        unsigned ee[16], rk[16];
#pragma unroll
        for (int i = 0; i < 16; ++i) ee[i] = (unsigned)EIDX[(size_t)(tk0 + (i >> 1)) * 128 + 64 * (i & 1) + lane] & 0x3fffu;
#pragma unroll
        for (int i = 0; i < 16; ++i) rk[i] = atomicAdd((unsigned*)&cnt[(ee[i] >> 11) * 8u + (unsigned)(i >> 1)], 1u);
        { const unsigned c = cnt[lane]; unsigned inc = c;
#pragma unroll
          for (int o = 1; o < 64; o <<= 1) { const unsigned n_ = __shfl_up(inc, o); if (lane >= o) inc += n_; }
          offreg = inc - c; off[lane] = offreg; }
#pragma unroll
        for (int i = 0; i < 16; ++i) list[off[(ee[i] >> 11) * 8u + (unsigned)(i >> 1)] + rk[i]] = ee[i] | ((unsigned)(i >> 1) << 14) | ((unsigned)(64 * (i & 1) + lane) << 17);
    }
    asm volatile("" ::: "memory");
    i32x8 B[8];
    {
        const int slot = fr >> 1;
        const bf16_t* hrow = H + (size_t)(tk0 + slot) * DM + 16 * fq;
        const float mx = HMAX[tk0 + slot];
        const float hs = mx > 0.f ? 224.f / mx : 1.f;
        const bool lo_part = (fr & 1) != 0;
#pragma unroll
        for (int mg = 0; mg < 4; ++mg) {
            u32x4 hv[2][4];
#pragma unroll
            for (int mm = 0; mm < 2; ++mm)
#pragma unroll
                for (int c = 0; c < 4; ++c) hv[mm][c] = *(const u32x4*)(hrow + 128 * (2 * mg + mm) + 64 * (c >> 1) + 8 * (c & 1));
            asm volatile("" ::: "memory");
#pragma unroll
            for (int mm = 0; mm < 2; ++mm) {
                i32x8 w;
#pragma unroll
                for (int c = 0; c < 4; ++c) { const u32x4 a = hv[mm][c];
                    w[2 * c] = (int)pk4_fp8(bflo(a.x) * hs, bfhi(a.x) * hs, bflo(a.y) * hs, bfhi(a.y) * hs);
                    w[2 * c + 1] = (int)pk4_fp8(bflo(a.z) * hs, bfhi(a.z) * hs, bflo(a.w) * hs, bfhi(a.w) * hs); }
                const i32x8 wz = {0, 0, 0, 0, 0, 0, 0, 0};
                B[2 * mg + mm] = lo_part ? wz : w;
            }
        }
    }
    {
        __builtin_amdgcn_s_waitcnt(0);
        const unsigned ringaddr = (unsigned)__builtin_amdgcn_readfirstlane((int)(unsigned)(uintptr_t)ringp);
        const unsigned lofs0 = (unsigned)(fr * 128 + (((unsigned)fq ^ (unsigned)((fr >> 1) & 7)) << 4)), lofs1 = (unsigned)(fr * 128 + (((unsigned)(4 + fq) ^ (unsigned)((fr >> 1) & 7)) << 4));
        const unsigned char* row1[2]; const unsigned char* row2[2];
        p9_rowptrs_q(row2, list, U8, 0, lane); p9_rowptrs_q(row1, list, U8, 1, lane);
        p9_dma_quarter(row2, 0, ringaddr); p9_dma_quarter(row2, 1, ringaddr + 2048u); p9_dma_quarter(row2, 2, ringaddr + 4096u); p9_dma_quarter(row2, 3, ringaddr + 6144u); p9_dma_quarter(row1, 0, ringaddr + 8192u);
        unsigned rb = 0u, wb = 5u * 2048u;
#define P9_UQ(Q, ROWS, QN) do { \
            asm volatile("s_waitcnt vmcnt(8)" ::: "memory"); \
            p9_mma_q<2 * (Q)>(acc, ringp + rb, lofs0, B); p9_mma_q<2 * (Q) + 1>(acc, ringp + rb, lofs1, B); \
            asm volatile("s_waitcnt lgkmcnt(0)" ::: "memory"); \
            p9_dma_quarter(ROWS, (QN), ringaddr + wb); \
            rb = rb + 2048u == 6u * 2048u ? 0u : rb + 2048u; wb = wb + 2048u == 6u * 2048u ? 0u : wb + 2048u; \
        } while (0)
#pragma unroll 1
        for (int b = 0; b < P9_NBATCH; ++b) {
            f32x4 acc = (f32x4){0.f, 0.f, 0.f, 0.f};
            p9_rowptrs_q(row2, list, U8, b + 2 < P9_NBATCH ? b + 2 : P9_NBATCH - 1, lane);
            P9_UQ(0, row1, 1); P9_UQ(1, row1, 2); P9_UQ(2, row1, 3); P9_UQ(3, row2, 0);
            p9_extract(acc, list, stage, actl, 16 * b, fr, fq);
            row1[0] = row2[0]; row1[1] = row2[1];
        }
#undef P9_UQ
        asm volatile("s_waitcnt vmcnt(0)" ::: "memory");
    }
    float sainv[8];
    {
        float av[16]; unsigned en[16]; float amax[8] = {0.f, 0.f, 0.f, 0.f, 0.f, 0.f, 0.f, 0.f};
#pragma unroll
        for (int k = 0; k < 16; ++k) {
            const unsigned ent = list[k * 64 + lane]; const unsigned e = ent & 0x3fffu, s_ = (ent >> 14) & 7u, idx = (ent >> 17) & 127u;
            const float d = __uint_as_float((unsigned)actl[s_ * 128 + idx] << 16);
            const float g = __uint_as_float((unsigned)EIDX[(size_t)(tk0 + s_) * 128 + idx] & 0xffff0000u), hi_ = HMAX[tk0 + s_] * (1.f / 224.f);
            av[k] = gelu_tanh(d * (SU[e] * hi_)) * (g * SV[e]); en[k] = ent;
#pragma unroll
            for (int q = 0; q < 8; ++q) amax[q] = fmaxf(amax[q], s_ == (unsigned)q ? fabsf(av[k]) : 0.f);
        }
        float sa[8];
#pragma unroll
        for (int q = 0; q < 8; ++q) { float m = amax[q];
#pragma unroll
            for (int o = 1; o < 64; o <<= 1) m = fmaxf(m, __shfl_xor(m, o));
            sa[q] = m > 0.f ? 224.f / m : 1.f; sainv[q] = m > 0.f ? m * (1.f / 224.f) : 1.f; }
        asm volatile("s_waitcnt lgkmcnt(0)" ::: "memory");
#pragma unroll
        for (int k = 0; k < 16; ++k) { const unsigned s_ = (en[k] >> 14) & 7u;
            float sc = sa[0];
#pragma unroll
            for (int q = 1; q < 8; ++q) sc = s_ == (unsigned)q ? sa[q] : sc;
            const unsigned b8 = (unsigned)__builtin_amdgcn_cvt_pk_fp8_f32(av[k] * sc, 0.f, 0, false) & 0xffu;
            list[k * 64 + lane] = (en[k] & 0x00ffffffu) | (b8 << 24); }
    }
    {
        LAS unsigned char* vring = wl + P9_VRING;
        f32x16 y[8];
#pragma unroll
        for (int s_ = 0; s_ < 8; ++s_)
#pragma unroll
            for (int r = 0; r < 16; ++r) y[s_][r] = 0.f;
        __builtin_amdgcn_s_waitcnt(0);
        const unsigned ringaddr = (unsigned)__builtin_amdgcn_readfirstlane((int)(unsigned)(uintptr_t)vring);
        const int j5 = lane & 31, kg = lane >> 5;
        const unsigned lo16 = 16u * (unsigned)j5;
        unsigned am[4];
#pragma unroll
        for (int d = 0; d < 4; ++d) am[d] = (kg == (j5 >> 4) && d == ((j5 & 15) >> 2)) ? (0xffu << (8 * (j5 & 3))) : 0u;
#define P9_VISSUE2E(m, ENT) do { const unsigned off_ = (((ENT) & 0x3fffu) << 9) | lo16; \
            const unsigned dst_ = (unsigned)__builtin_amdgcn_readfirstlane((int)(ringaddr + ((((unsigned)(m)) & 31u) << 9))); \
            asm volatile("s_mov_b32 m0, %2\n\ts_nop 0\n\tglobal_load_lds_dwordx4 %0, %1" :: "v"(off_), "s"(V8), "s"(dst_) : "memory", "m0"); } while (0)
#pragma unroll 1
        for (int m_ = 0; m_ < 32; m_ += 2) P9_VISSUE2E(m_, list[m_ + kg]);
        int n = 0, iss = 32;
        asm volatile("s_waitcnt vmcnt(14)" ::: "memory");
        u32x4 bq = *(const LAS u32x4*)(vring + (((unsigned)kg) << 9) + lo16);
        unsigned a0q = list[0], a1q = list[1], enq = list[32 + kg];
#define P9_VPAIR(S, TWO) do { \
            asm volatile("s_waitcnt lgkmcnt(0)" ::: "memory");        \
            const int nn_ = n + ((TWO) ? 2 : 1); const bool doi_ = iss <= nn_ + 30; \
            const unsigned a0_ = __builtin_amdgcn_perm(a0q, a0q, 0x03030303u), a1_ = (TWO) ? __builtin_amdgcn_perm(a1q, a1q, 0x03030303u) : 0u;     \
            const i32x8 am_ = {(int)(a0_ & am[0]), (int)(a0_ & am[1]), (int)(a0_ & am[2]), (int)(a0_ & am[3]), (int)(a1_ & am[0]), (int)(a1_ & am[1]), (int)(a1_ & am[2]), (int)(a1_ & am[3])}; \
            const i32x8 bm_ = {(int)bq.x, (int)bq.y, (int)bq.z, (int)bq.w, 0, 0, 0, 0}; \
            y[S] = __builtin_amdgcn_mfma_scale_f32_32x32x64_f8f6f4(am_, bm_, y[S], 0  , 4  , 0, 0x7f7f7f7f, 0, 0x7f7f7f7f); \
            if (doi_) { P9_VISSUE2E(iss, enq); iss += 2; } \
            asm volatile("s_waitcnt vmcnt(13)" ::: "memory"); \
            bq = *(const LAS u32x4*)(vring + ((((unsigned)(nn_ + kg)) & 31u) << 9) + lo16); \
            a0q = list[nn_]; a1q = list[nn_ + 1]; \
            { const int mi_ = iss + kg; enq = list[mi_ < P9_NENT ? mi_ : P9_NENT - 1]; } \
        } while (0)
#define P9_VSEG(S, END) do { const int end_ = (END); \
            _Pragma("unroll 1") for (; n + 1 < end_; n += 2) P9_VPAIR(S, true); \
            if (n < end_) { P9_VPAIR(S, false); ++n; } } while (0)
#pragma unroll 1
        for (int b = 0; b < 8; ++b) {
            P9_VSEG(0, __builtin_amdgcn_readlane((int)offreg, 8 * b + 1));
            P9_VSEG(1, __builtin_amdgcn_readlane((int)offreg, 8 * b + 2));
            P9_VSEG(2, __builtin_amdgcn_readlane((int)offreg, 8 * b + 3));
            P9_VSEG(3, __builtin_amdgcn_readlane((int)offreg, 8 * b + 4));
            P9_VSEG(4, __builtin_amdgcn_readlane((int)offreg, 8 * b + 5));
            P9_VSEG(5, __builtin_amdgcn_readlane((int)offreg, 8 * b + 6));
            P9_VSEG(6, __builtin_amdgcn_readlane((int)offreg, 8 * b + 7));
            P9_VSEG(7, (b < 7) ? __builtin_amdgcn_readlane((int)offreg, (8 * b + 8) & 63) : P9_NENT);
        }
        asm volatile("s_waitcnt vmcnt(0)" ::: "memory");
        const int bsel = tk0 / SEQ; const int eo = 32 * j5 + 4 * kg;
        f32x4 gtg[4];
#pragma unroll
        for (int u = 0; u < 4; ++u) gtg[u] = *(const f32x4*)(mod + bsel * NMOD + 5 * DM + 8 * u + eo) * *(const f32x4*)(p.g_post_ffn + 8 * u + eo);
#pragma unroll
        for (int s_ = 0; s_ < 8; ++s_) {
            const int t_ = tk0 + s_;
            f32x4 yy[4];
            float ss = 0.f;
#pragma unroll
            for (int u = 0; u < 4; ++u) { yy[u] = (f32x4){y[s_][4 * u], y[s_][4 * u + 1], y[s_][4 * u + 2], y[s_][4 * u + 3]} * sainv[s_]; ss += yy[u][0] * yy[u][0] + yy[u][1] * yy[u][1] + yy[u][2] * yy[u][2] + yy[u][3] * yy[u][3]; }
            const float rstd = rsqrtf(wave_sum_dpp(ss) * (1.f / DM) + RMS_EPS);
            float* orow = p.out + (size_t)t_ * DM + eo; const bf16_t* xrow = (const bf16_t*)(p.ws + WS_X1) + (size_t)t_ * DM + eo;
#pragma unroll
            for (int u = 0; u < 4; ++u) { const u32x2 xb = *(const u32x2*)(xrow + 8 * u); const f32x4 x1 = {bflo(xb.x), bfhi(xb.x), bflo(xb.y), bfhi(xb.y)}; *(f32x4*)(orow + 8 * u) = x1 + gtg[u] * (yy[u] * rstd); }
        }
        asm volatile("s_waitcnt lgkmcnt(0)" ::: "memory");
    }
}

#define XB_TMO      128
#define XB_XCNT(j)  (256  + 64 * (j))
#define XB_XSUB(j)  (1280 + 64 * (j))
#define XB_XGEN(j)  (2304 + 64 * (j))
#define XB_TOP      3328
#define XB_TOPGEN   3392
#define XCD_BAR_WORDS 3456
#define XB_SPIN_CAP (1u << 18)

__device__ __forceinline__ unsigned xb_ld(unsigned* p)              { return __hip_atomic_load(p, __ATOMIC_RELAXED, __HIP_MEMORY_SCOPE_AGENT); }
__device__ __forceinline__ unsigned xb_add(unsigned* p, unsigned v) { return __hip_atomic_fetch_add(p, v, __ATOMIC_RELAXED, __HIP_MEMORY_SCOPE_AGENT); }
__device__ __forceinline__ unsigned xb_xcc_id() { return (unsigned)__builtin_amdgcn_s_getreg((3 << 11) | 20) & 0xFu; }
#define XB_SPIN(cond, bar) do { unsigned _sp = 0; while (cond) { __builtin_amdgcn_s_sleep(1); \
    if ((++_sp & 255u) == 0u) { if (xb_ld(&(bar)[XB_TMO])) break; if (_sp > XB_SPIN_CAP) { atomicAdd(&(bar)[XB_TMO], 1u); break; } } } } while (0)

struct XcdBarrier {
    unsigned* bar; unsigned x;
    volatile LAS unsigned* st;
};

__device__ __forceinline__ XcdBarrier xcd_barrier_post(unsigned* bar, volatile LAS unsigned* st) {
    XcdBarrier b; b.bar = bar; b.x = xb_xcc_id(); b.st = st;
    if (threadIdx.x == 0) (void)xb_add(&bar[XB_XCNT(b.x)], 1u);
    return b;
}
__device__ __forceinline__ void xcd_barrier_complete(unsigned* bar, unsigned x, unsigned& nloc, unsigned& nx) {
    const unsigned G = gridDim.x * gridDim.y * gridDim.z;
    unsigned sum, cnt, mine, sp = 0u;
    for (;;) {
        sum = 0u; cnt = 0u; mine = 0u;
#pragma unroll
        for (unsigned j = 0; j < 16; ++j) { const unsigned c = xb_ld(&bar[XB_XCNT(j)]); sum += c; cnt += (c > 0u) ? 1u : 0u; mine = (j == x) ? c : mine; }
        if (sum == G) break;
        __builtin_amdgcn_s_sleep(1);
        if ((++sp & 255u) == 0u) { if (xb_ld(&bar[XB_TMO])) break; if (sp > XB_SPIN_CAP) { atomicAdd(&bar[XB_TMO], 1u); break; } }
    }
    nloc = mine > 0u ? mine : 1u; nx = cnt > 0u ? cnt : 1u;
}

__device__ __forceinline__ void xcd_barrier(const XcdBarrier& b) {
    asm volatile("s_waitcnt vmcnt(0)" ::: "memory");
    __syncthreads();
    if (threadIdx.x == 0) {
        unsigned* bar = b.bar;
        __builtin_amdgcn_s_waitcnt(0);
        unsigned nloc = b.st[0], nx = b.st[1];
        if (nloc == 0u) { xcd_barrier_complete(bar, b.x, nloc, nx); b.st[0] = nloc; b.st[1] = nx; }
        const unsigned old = xb_add(&bar[XB_XSUB(b.x)], 1u);
        const unsigned gen = old / nloc;
        if (old + 1u == (gen + 1u) * nloc) {
            __builtin_amdgcn_fence(__ATOMIC_RELEASE, "agent");
            asm volatile("s_waitcnt vmcnt(0)" ::: "memory");
            const unsigned og = xb_add(&bar[XB_TOP], 1u);
            const unsigned tg = og / nx;
            if (og + 1u == (tg + 1u) * nx) xb_add(&bar[XB_TOPGEN], 1u);
            else XB_SPIN(xb_ld(&bar[XB_TOPGEN]) == tg, bar);
            __builtin_amdgcn_fence(__ATOMIC_ACQUIRE, "agent");
            xb_add(&bar[XB_XGEN(b.x)], 1u);
            asm volatile("s_waitcnt vmcnt(0)" ::: "memory");
        } else {
            XB_SPIN(xb_ld(&bar[XB_XGEN(b.x)]) == gen, bar);
            __builtin_amdgcn_fence(__ATOMIC_ACQUIRE, "agent");
            asm volatile("s_waitcnt vmcnt(0)" ::: "memory");
        }
    }
    __syncthreads();
}


__global__ void __launch_bounds__(NTHREADS, 2) fwd_kernel(Params p) {
    extern __shared__ __attribute__((aligned(16))) unsigned char lds_raw[];
    LAS unsigned char* lds = (LAS unsigned char*)lds_raw;
    volatile LAS unsigned* bst = (volatile LAS unsigned*)(lds + LDS_BYTES - 16);
    if (threadIdx.x < 4) bst[threadIdx.x] = 0u;
    __syncthreads();
    const XcdBarrier xbar = xcd_barrier_post((unsigned*)(p.ws + WS_BAR), bst);
#define GRID_BAR() xcd_barrier(xbar)

    REPEAT(1, phase0(p, lds));
    GRID_BAR();
    REPEAT(2, phase1(p, lds));
    GRID_BAR();
    scan_kb(p, lds);
    REPEAT(3, {
        pg8::Gemm g{(const bf16_t*)(p.ws + WS_H), (const bf16_t*)(p.ws + WS_WTIN), T, NPROJ, DM};
        pg8::StaticOrder S; S.init(T, NPROJ, gridDim.x, blockIdx.x);
        pg8::EpiBf16 E{(bf16_t*)(p.ws + WS_PROJ), NPROJ, 0xC3u, C2};
        pg8::gemm_phase<pg8::EpiBf16, pg8::StaticOrder>(lds, g, S, E);
    });
    GRID_BAR();
    REPEAT(4, { fox_prepass(p); phase_swa(p, lds); });
    GRID_BAR();
    REPEAT(5, phase_fox(p, lds));
    GRID_BAR();
    REPEAT(6, {
        pg8::Gemm g{(const bf16_t*)(p.ws + WS_ATT), (const bf16_t*)(p.ws + WS_WTOUT), T, DM, DM};
        pg8::StaticOrder S; S.init(T, DM, gridDim.x, blockIdx.x);
        pg8::EpiBf16 E{(bf16_t*)(p.ws + WS_PROJ), DM, 0u, 1.f};
        pg8::gemm_phase<pg8::EpiBf16, pg8::StaticOrder>(lds, g, S, E);
    });
    GRID_BAR();
    REPEAT(7, phase6(p));
    GRID_BAR();
    REPEAT(8, {
        pg8::Gemm g{(const bf16_t*)(p.ws + WS_H), (const bf16_t*)(p.ws + WS_WTQ), T, 2048, DM};
        pg8::StaticOrder S; S.init(T, 2048, gridDim.x, blockIdx.x);
        pg8::EpiBf16 E{(bf16_t*)(p.ws + WS_PROJ), 2048, 0u, 1.f};
        pg8::gemm_phase<pg8::EpiBf16, pg8::StaticOrder>(lds, g, S, E);
    });
    GRID_BAR();
    for (int tb = blockIdx.x * 128; tb < T; tb += gridDim.x * 128) {
        REPEAT(9, { const int t8 = fresh_tid(); phase8_block(p, lds, tb + 16 * (t8 >> 6), __builtin_amdgcn_readfirstlane(t8 >> 6), t8 & 63); });
        __builtin_amdgcn_fence(__ATOMIC_RELEASE, "workgroup");
        asm volatile("s_waitcnt vmcnt(0)" ::: "memory");
        __builtin_amdgcn_fence(__ATOMIC_ACQUIRE, "workgroup");
        __syncthreads();
#pragma unroll 1
        for (int i = 0; i < 2; ++i) { const int t9 = fresh_tid(); phase9_pass(p, lds + (t9 >> 6) * P9_WAVE_LDS, tb + 16 * (t9 >> 6) + 8 * i, t9 & 63); }
    }
}

extern "C" void kernel_launch(void* const* d_in, const int* in_sizes, int n_in, void* d_out, int out_size, void* d_ws, size_t ws_size, hipStream_t stream) {
    static int grid_blocks = 0;
    if (grid_blocks == 0) {
        if (n_in != 16 || out_size != T * DM || ws_size < WS_END) { fprintf(stderr, "kernel_launch: unexpected shapes (n_in %d out %d ws %zu)\n", n_in, out_size, ws_size); grid_blocks = -1; return; }
        int dev = 0, cus = 0, per_cu = 0;
        (void)hipGetDevice(&dev);
        (void)hipDeviceGetAttribute(&cus, hipDeviceAttributeMultiprocessorCount, dev);
        (void)hipFuncSetAttribute((const void*)fwd_kernel, hipFuncAttributeMaxDynamicSharedMemorySize, LDS_BYTES);
        (void)hipOccupancyMaxActiveBlocksPerMultiprocessor(&per_cu, (const void*)fwd_kernel, NTHREADS, LDS_BYTES);
        if (per_cu < 1) { fprintf(stderr, "kernel_launch: occupancy query says %d blocks per CU\n", per_cu); per_cu = 1; }
        grid_blocks = cus;
        fprintf(stderr, "kernel_launch: grid %d (cus %d, per_cu %d)\n", grid_blocks, cus, per_cu);
    }
    if (grid_blocks < 0) return;
    Params p{};
    p.x = (const float*)d_in[0]; p.c = (const float*)d_in[1]; p.w_ada = (const float*)d_in[2]; p.b_ada = (const float*)d_in[3];
    p.g_pre_mix = (const float*)d_in[4]; p.g_post_mix = (const float*)d_in[5]; p.g_pre_ffn = (const float*)d_in[6]; p.g_post_ffn = (const float*)d_in[7];
    p.w_in = (const float*)d_in[8]; p.b_fgate = (const float*)d_in[9]; p.swa_sinks = (const float*)d_in[10]; p.w_out = (const float*)d_in[11];
    p.w_query = (const float*)d_in[12]; p.sub_keys = (const float*)d_in[13]; p.w_u = (const float*)d_in[14]; p.w_v = (const float*)d_in[15];
    p.out = (float*)d_out; p.ws = (unsigned char*)d_ws;
    (void)hipMemsetAsync((unsigned char*)d_ws + WS_BAR, 0, 16384, stream);
    void* args[] = {&p};
    hipError_t e = hipLaunchCooperativeKernel((void*)fwd_kernel, dim3(grid_blocks), dim3(NTHREADS), args, LDS_BYTES, stream);
    if (e != hipSuccess) fprintf(stderr, "kernel_launch: cooperative launch failed: %s (grid %d)\n", hipGetErrorString(e), grid_blocks);
}
```

```cpp
#include <hip/hip_runtime.h>
#include <hip/hip_cooperative_groups.h>
#include <cstdio>
#include <cstdint>
namespace cg = cooperative_groups;

#define LAS __attribute__((address_space(3)))
typedef unsigned short bf16_t;
typedef short bf16x8 __attribute__((ext_vector_type(8)));
typedef short s16x4 __attribute__((ext_vector_type(4)));
typedef float f32x4 __attribute__((ext_vector_type(4)));
typedef float f32x16 __attribute__((ext_vector_type(16)));
typedef unsigned u32x4 __attribute__((ext_vector_type(4)));
typedef unsigned u32x2 __attribute__((ext_vector_type(2)));
typedef float f32x2_t __attribute__((ext_vector_type(2)));
typedef __bf16 bf16x2_t __attribute__((ext_vector_type(2)));

constexpr int BATCH = 4, SEQ = 8192, DM = 1024, T = BATCH * SEQ;
constexpr int NPROJ = 2304, INW = 2312;
constexpr int NMOD = 6 * DM;
constexpr float RMS_EPS = 1e-6f;
constexpr float LOG2E = 1.4426950408889634f;
constexpr float C2 = 0.125f * LOG2E;
constexpr float NEGBIG = -1e30f;

constexpr size_t MiB = 1u << 20;
constexpr size_t WS_MOD = 0, WS_WF = 128 * 1024, WS_KT = 256 * 1024  , WS_BAR = 512 * 1024  , WS_CMAX = 528 * 1024  , WS_HMAX = 640 * 1024  , WS_LS = 1 * MiB, WS_KB = 2 * MiB;
constexpr size_t WS_WTIN = 4 * MiB, WS_WTOUT = 10 * MiB, WS_WTQ = 12 * MiB, WS_SK = 16 * MiB;
constexpr size_t WS_U8 = 32 * MiB, WS_V8 = 48 * MiB, WS_SU = 64 * MiB, WS_SV = 64 * MiB + 65536, WS_H = 96 * MiB, WS_ATT = 160 * MiB, WS_PROJ = 224 * MiB;
constexpr size_t WS_EIDX = 160 * MiB, WS_GATE = 176 * MiB  , WS_X1 = 352 * MiB, WS_END = 480 * MiB;

constexpr int NTHREADS = 512, NWAVES = 8;
#define REP_PHASE 0
#define REPEAT(k, ...) do { __VA_ARGS__; if (REP_PHASE == (k)) { __syncthreads(); __VA_ARGS__; } } while (0)
constexpr int LDS_BYTES = 163840;

__device__ __forceinline__ unsigned cvtpk(float lo, float hi) { f32x2_t v = {lo, hi}; bf16x2_t b = __builtin_convertvector(v, bf16x2_t); return __builtin_bit_cast(unsigned, b); }
__device__ __forceinline__ float bflo(unsigned w) { return __uint_as_float(w << 16); }
__device__ __forceinline__ float bfhi(unsigned w) { return __uint_as_float(w & 0xffff0000u); }
__device__ __forceinline__ float wave_sum(float v) {
#pragma unroll
    for (int o = 1; o < 64; o <<= 1) v += __shfl_xor(v, o);
    return v;
}
__device__ __forceinline__ float vmaxf(float a, float b) { float r; asm("v_max_f32_e32 %0, %1, %2" : "=v"(r) : "v"(a), "v"(b)); return r; }
__device__ __forceinline__ float vminf(float a, float b) { float r; asm("v_min_f32_e32 %0, %1, %2" : "=v"(r) : "v"(a), "v"(b)); return r; }
__device__ __forceinline__ int fresh_tid() { int t = threadIdx.x; asm volatile("" : "+v"(t)); return t; }
__device__ __forceinline__ int crow(int r, int hi) { return (r & 3) + 8 * (r >> 2) + 4 * hi; }

namespace pg8 {
constexpr int BM = 256, BK = 64, HALF = 128, HTB = HALF * BK * 2, STAGE_BYTES = 8 * HTB, NXCD = 8, WGM = 8;
__host__ __device__ __forceinline__ int lds_byte(int r, int c) { const int st = (r >> 4) * 2 + (c >> 5), rr = r & 15, cc = c & 31, ob = rr * 64 + cc * 2; return st * 1024 + (ob ^ (((ob >> 9) & 1) << 5)); }
__host__ __device__ __forceinline__ void stage_rc(int b, int& R, int& C) { const int st = b / 1024, sb = b % 1024, swz = sb ^ (((sb >> 9) & 1) << 5); R = (st >> 1) * 16 + swz / 64; C = (st & 1) * 32 + (swz % 64) / 2; }
__host__ __device__ __forceinline__ int perm32(int rho) { const int n = rho >> 4, i = rho & 15; return 8 * (i >> 2) + 4 * n + (i & 3); }
struct Unit { int pm, pn; };
struct Gemm { const bf16_t* A; const bf16_t* Bt; int M, N, K; const unsigned char* ea; const unsigned char* eb; };
struct StaticOrder {
    int nM, nN, nwg, G, c;
    __device__ void init(int M, int N, int G_, int c_) { nM = M / BM; nN = N / BM; nwg = nM * nN; G = G_; c = c_; }
    __device__ bool next(int i, Unit& u) const {
        const long L = (long)i * G + c; if (L >= nwg) return false;
        int wgid = (int)L; { const int q = nwg / NXCD, r = nwg % NXCD, xcd = wgid % NXCD, off = wgid / NXCD; wgid = (xcd < r ? xcd * (q + 1) : r * (q + 1) + (xcd - r) * q) + off; }
        const int nig = WGM * nN, gid = wgid / nig, fm = gid * WGM, gsz = (nM - fm) < WGM ? (nM - fm) : WGM;
        u.pm = fm + ((wgid % nig) % gsz); u.pn = (wgid % nig) / gsz; return true;
    }
};
struct EpiBf16 {
    static constexpr bool PERM = true;
    bf16_t* O; int ldc; unsigned scale_mask; float sc;
    __device__ __forceinline__ void operator()(const f32x4 (&acc)[2][2][4][2], const Unit& u, int wr, int wc, int fr, int fq) const {
        const int row0 = u.pm * BM + wr * 64 + fr; const int col0 = u.pn * BM + wc * 32 + 8 * fq;
        const float s = ((scale_mask >> u.pn) & 1u) ? sc : 1.f;
#pragma unroll
        for (int ai = 0; ai < 2; ++ai)
#pragma unroll
            for (int m = 0; m < 4; ++m) { bf16_t* rowp = O + (size_t)(row0 + ai * HALF + m * 16) * ldc + col0;
#pragma unroll
                for (int bj = 0; bj < 2; ++bj) { const f32x4 v0 = acc[ai][bj][m][0] * s, v1 = acc[ai][bj][m][1] * s;
                    u32x4 w; w.x = cvtpk(v0[0], v0[1]); w.y = cvtpk(v0[2], v0[3]); w.z = cvtpk(v1[0], v1[1]); w.w = cvtpk(v1[2], v1[3]);
                    *(u32x4*)(rowp + bj * HALF) = w; } }
    }
};

template <class Epi, class Sched, bool FP8 = false>
__device__ __forceinline__ void gemm_phase(LAS unsigned char* lds, const Gemm g, const Sched& S, const Epi& E) {
    const int tid = fresh_tid(), wid = __builtin_amdgcn_readfirstlane(tid >> 6), lane = tid & 63, wr = wid >> 2, wc = wid & 3, fr = lane & 15, fq = lane >> 4;
    int K = g.K; asm volatile("" : "+s"(K));
    const int nt = K / BK;
    unsigned voffA[2], voffB[2];
#pragma unroll
    for (int i = 0; i < 2; ++i) { int R, C; stage_rc(tid * 16 + i * 8192, R, C); const int Rb = Epi::PERM ? ((R & ~31) + perm32(R & 31)) : R;
        voffA[i] = (unsigned)(R * K + C) * 2u; voffB[i] = (unsigned)(Rb * K + C) * 2u; }
    const size_t kstep = (size_t)(BK * 2);
    const size_t hstep = (size_t)HALF * K * 2;
    const size_t tstep = 2 * hstep;
    const unsigned ldsw = (unsigned)wid * 1024u;
    const int aoff = lds_byte(wr * 64 + fr, fq * 8), boff = lds_byte(wc * 32 + fr, fq * 8);
    const LAS unsigned char* abase = lds + aoff; const LAS unsigned char* bbase = lds + boff;
#define PG8_SA(b, h) (((b) * 2 + (h)) * HTB)
#define PG8_SB(b, h) ((4 + (b) * 2 + (h)) * HTB)
#define PG8_STAGE(bufoff, gbase, voff) do { _Pragma("unroll") for (int _i = 0; _i < 2; ++_i) \
        __builtin_amdgcn_global_load_lds((const unsigned*)((const char*)(gbase) + (voff)[_i]), (LAS unsigned*)(lds + (bufoff) + ldsw + _i * 8192), 16, 0, 0); } while (0)
#define PG8_LD8(dst8, basep, off) do { const u32x4 lo_ = *(const LAS u32x4*)((basep) + (off)), hi_ = *(const LAS u32x4*)((basep) + (off) + 1024); \
        dst8 = (i32x8_t){(int)lo_.x, (int)lo_.y, (int)lo_.z, (int)lo_.w, (int)hi_.x, (int)hi_.y, (int)hi_.z, (int)hi_.w}; } while (0)
#define PG8_LDA(dst, b, h) do { _Pragma("unroll") for (int m = 0; m < 4; ++m) { if constexpr (FP8) PG8_LD8(dst##8[m], abase, PG8_SA(b, h) + m * 2048); \
        else { _Pragma("unroll") for (int k = 0; k < 2; ++k) dst[m][k] = *(const LAS bf16x8*)(lds + PG8_SA(b, h) + aoff + m * 2048 + k * 1024); } } } while (0)
#define PG8_LDB(dst, b, h) do { _Pragma("unroll") for (int n = 0; n < 2; ++n) { if constexpr (FP8) PG8_LD8(dst##8[n], bbase, PG8_SB(b, h) + n * 2048); \
        else { _Pragma("unroll") for (int k = 0; k < 2; ++k) dst[n][k] = *(const LAS bf16x8*)(lds + PG8_SB(b, h) + boff + n * 2048 + k * 1024); } } } while (0)
#define PG8_MM8(ai, bj, At, Bt, m, n) asm volatile("v_mfma_scale_f32_16x16x128_f8f6f4 %0, %1, %2, %0, %3, %4 op_sel:[%5,%6,0] op_sel_hi:[%7,%8,0]" \
        : "+v"(acc[ai][bj][m][n]) : "v"(Bt##8[n]), "v"(At##8[m]), "v"(wscale), "v"((ai) ? ascale1 : ascale0), "i"(((bj) * 2 + (n)) & 1), "i"((m) & 1), "i"(((bj) * 2 + (n)) >> 1), "i"((m) >> 1))
#define PG8_MMA(ai, bj, At, Bt) do { __builtin_amdgcn_s_setprio(1); \
        if constexpr (FP8) { PG8_MM8(ai, bj, At, Bt, 0, 0); PG8_MM8(ai, bj, At, Bt, 0, 1); PG8_MM8(ai, bj, At, Bt, 1, 0); PG8_MM8(ai, bj, At, Bt, 1, 1); \
                             PG8_MM8(ai, bj, At, Bt, 2, 0); PG8_MM8(ai, bj, At, Bt, 2, 1); PG8_MM8(ai, bj, At, Bt, 3, 0); PG8_MM8(ai, bj, At, Bt, 3, 1); } \
        else { _Pragma("unroll") for (int m = 0; m < 4; ++m) _Pragma("unroll") for (int n = 0; n < 2; ++n) _Pragma("unroll") for (int k = 0; k < 2; ++k) \
            acc[ai][bj][m][n] = __builtin_amdgcn_mfma_f32_16x16x32_bf16(Bt[n][k], At[m][k], acc[ai][bj][m][n], 0, 0, 0); } \
        __builtin_amdgcn_s_setprio(0); } while (0)
#define PG8_WAIT_V(n) asm volatile("s_waitcnt vmcnt(" #n ")" ::: "memory")
#define PG8_WAIT_L(n) asm volatile("s_waitcnt lgkmcnt(" #n ")" ::: "memory")
#define PG8_BAR __builtin_amdgcn_s_barrier()
#define PG8_SCHED __builtin_amdgcn_sched_barrier(0)
    Unit cur, nxt; int ui = 0;
    if (!S.next(0, cur)) return;
    unsigned ascale0 = 0x7f7f7f7fu, ascale1 = 0x7f7f7f7fu, wscale = 0x7f7f7f7fu;
#define PG8_LDSCALES(u) do { if constexpr (FP8) { const unsigned char* ea_ = g.ea + (size_t)(u).pm * BM + wr * 64 + fr; const unsigned char* eb_ = g.eb + (size_t)(u).pn * BM + wc * 32; \
        ascale0 = (unsigned)ea_[0] | ((unsigned)ea_[16] << 8) | ((unsigned)ea_[32] << 16) | ((unsigned)ea_[48] << 24); \
        ascale1 = (unsigned)ea_[HALF] | ((unsigned)ea_[HALF + 16] << 8) | ((unsigned)ea_[HALF + 32] << 16) | ((unsigned)ea_[HALF + 48] << 24); \
        wscale = (unsigned)eb_[perm32(fr)] | ((unsigned)eb_[perm32(16 + fr)] << 8) | ((unsigned)eb_[HALF + perm32(fr)] << 16) | ((unsigned)eb_[HALF + perm32(16 + fr)] << 24); } } while (0)
    PG8_LDSCALES(cur);
    f32x4 acc[2][2][4][2];
#pragma unroll
    for (int a = 0; a < 2; ++a)
#pragma unroll
        for (int b = 0; b < 2; ++b)
#pragma unroll
            for (int m = 0; m < 4; ++m)
#pragma unroll
                for (int n = 0; n < 2; ++n) acc[a][b][m][n] = (f32x4){0.f, 0.f, 0.f, 0.f};
    typedef int i32x8_t __attribute__((ext_vector_type(8)));
    bf16x8 At[4][2], B0[2][2], B1[2][2]; i32x8_t At8[4], B08[2], B18[2];
    const char* cA = (const char*)g.A + (size_t)cur.pm * tstep; const char* cB = (const char*)g.Bt + (size_t)cur.pn * tstep;
    PG8_STAGE(PG8_SB(0, 0), cB, voffB); PG8_STAGE(PG8_SA(0, 0), cA, voffA); PG8_STAGE(PG8_SB(0, 1), cB + hstep, voffB); PG8_STAGE(PG8_SA(0, 1), cA + hstep, voffA);
    if (wr == 1) PG8_BAR;
    PG8_WAIT_V(4); PG8_BAR;
    PG8_STAGE(PG8_SB(1, 0), cB + kstep, voffB); PG8_STAGE(PG8_SA(1, 0), cA + kstep, voffA); PG8_STAGE(PG8_SB(1, 1), cB + hstep + kstep, voffB);
    PG8_WAIT_V(6); PG8_BAR;
    for (;;) {
        const bool has_next = S.next(ui + 1, nxt);
        const char* nA = has_next ? (const char*)g.A + (size_t)nxt.pm * tstep : cA; const char* nB = has_next ? (const char*)g.Bt + (size_t)nxt.pn * tstep : cB;
#pragma unroll 1
        for (int t = 0; t < nt; t += 2) {
            const bool last = (t == nt - 2);
            const char* a1 = cA + (size_t)(t + 1) * kstep;
            const char* a2 = last ? nA : cA + (size_t)(t + 2) * kstep; const char* b2 = last ? nB : cB + (size_t)(t + 2) * kstep;
            const char* a3 = a2 + kstep; const char* b3 = b2 + kstep;
            PG8_LDB(B0, 0, 0); PG8_SCHED; PG8_LDA(At, 0, 0); PG8_STAGE(PG8_SA(1, 1), a1 + hstep, voffA);
            PG8_WAIT_L(8); PG8_BAR; PG8_WAIT_L(0); PG8_MMA(0, 0, At, B0); PG8_BAR; PG8_SCHED;
            PG8_LDB(B1, 0, 1); PG8_STAGE(PG8_SB(0, 0), b2, voffB);
            PG8_BAR; PG8_WAIT_L(0); PG8_MMA(0, 1, At, B1); PG8_BAR;
            PG8_LDA(At, 0, 1); PG8_STAGE(PG8_SA(0, 0), a2, voffA);
            PG8_BAR; PG8_WAIT_L(0); PG8_MMA(1, 0, At, B0); PG8_BAR; PG8_SCHED;
            PG8_STAGE(PG8_SB(0, 1), b2 + hstep, voffB);
            PG8_WAIT_V(6); PG8_BAR; PG8_MMA(1, 1, At, B1); PG8_BAR;
            PG8_LDB(B0, 1, 0); PG8_SCHED; PG8_LDA(At, 1, 0); PG8_STAGE(PG8_SA(0, 1), a2 + hstep, voffA);
            PG8_WAIT_L(8); PG8_BAR; PG8_WAIT_L(0); PG8_MMA(0, 0, At, B0); PG8_BAR; PG8_SCHED;
            PG8_LDB(B1, 1, 1); PG8_STAGE(PG8_SB(1, 0), b3, voffB);
            PG8_BAR; PG8_WAIT_L(0); PG8_MMA(0, 1, At, B1); PG8_BAR;
            PG8_LDA(At, 1, 1); PG8_STAGE(PG8_SA(1, 0), a3, voffA);
            PG8_BAR; PG8_WAIT_L(0); PG8_MMA(1, 0, At, B0); PG8_BAR; PG8_SCHED;
            PG8_STAGE(PG8_SB(1, 1), b3 + hstep, voffB);
            PG8_WAIT_V(6); PG8_BAR; PG8_MMA(1, 1, At, B1); PG8_BAR;
        }
        if constexpr (FP8) asm volatile("s_nop 15\n\ts_nop 15" ::: "memory");
        E(acc, cur, wr, wc, fr, fq);
        if (!has_next) break;
#pragma unroll
        for (int a = 0; a < 2; ++a)
#pragma unroll
            for (int b = 0; b < 2; ++b)
#pragma unroll
                for (int m = 0; m < 4; ++m)
#pragma unroll
                    for (int n = 0; n < 2; ++n) acc[a][b][m][n] = (f32x4){0.f, 0.f, 0.f, 0.f};
        cur = nxt; cA = nA; cB = nB; ++ui;
        PG8_LDSCALES(cur);
    }
    PG8_WAIT_V(0);
    if (wr == 0) PG8_BAR;
    PG8_BAR;
#undef PG8_SA
#undef PG8_SB
#undef PG8_STAGE
#undef PG8_LD8
#undef PG8_LDSCALES
#undef PG8_LDA
#undef PG8_LDB
#undef PG8_MM8
#undef PG8_MMA
#undef PG8_WAIT_V
#undef PG8_WAIT_L
#undef PG8_BAR
#undef PG8_SCHED
}
}

struct Params {
    const float *x, *c, *w_ada, *b_ada, *g_pre_mix, *g_post_mix, *g_pre_ffn, *g_post_ffn, *w_in, *b_fgate, *swa_sinks, *w_out, *w_query, *sub_keys, *w_u, *w_v;
    float* out; unsigned char* ws;
};

__device__ __forceinline__ void phase0(const Params& p, LAS unsigned char* lds) {
    const int tid = fresh_tid();
    float* mod = (float*)(p.ws + WS_MOD);
    if (blockIdx.x < NMOD / 32) {
        LAS float* sc = (LAS float*)lds;
        LAS float* red = (LAS float*)(lds + 16384);
        for (int i = tid; i < BATCH * DM; i += NTHREADS) { const float cv = p.c[i]; sc[i] = cv / (1.f + __expf(-cv)); }
        __syncthreads();
        const int cl = tid & 31, ks = tid >> 5, col = blockIdx.x * 32 + cl;
        float a0 = 0.f, a1 = 0.f, a2 = 0.f, a3 = 0.f;
#pragma unroll 32
        for (int k = ks * 64; k < ks * 64 + 64; ++k) { const float w = p.w_ada[(size_t)k * NMOD + col]; a0 += sc[k] * w; a1 += sc[DM + k] * w; a2 += sc[2 * DM + k] * w; a3 += sc[3 * DM + k] * w; }
        red[(ks * 4 + 0) * 32 + cl] = a0; red[(ks * 4 + 1) * 32 + cl] = a1; red[(ks * 4 + 2) * 32 + cl] = a2; red[(ks * 4 + 3) * 32 + cl] = a3;
        __syncthreads();
        if (tid < 128) { const int b = tid >> 5, c2 = tid & 31; float s = 0.f;
#pragma unroll
            for (int k = 0; k < 16; ++k) s += red[(k * 4 + b) * 32 + c2];
            mod[b * NMOD + blockIdx.x * 32 + c2] = s + p.b_ada[blockIdx.x * 32 + c2]; }
        __syncthreads();
    }
    const size_t gt = (size_t)blockIdx.x * NTHREADS + tid, ng = (size_t)gridDim.x * NTHREADS;
    {
        const int lane = tid & 63, gw = blockIdx.x * NWAVES + (tid >> 6), ngw = gridDim.x * NWAVES;
        unsigned char* U6 = p.ws + WS_U8; unsigned char* V8 = p.ws + WS_V8; float* SU = (float*)(p.ws + WS_SU); float* SV = (float*)(p.ws + WS_SV);
        for (int r = gw; r < 8192 + 8192; r += ngw) {
            const bool isv = r < 8192;
            const int e = 2 * (isv ? r : r - 8192) + (lane >> 5), l32 = lane & 31;
            const float* src = (isv ? p.w_v : p.w_u) + (size_t)e * DM + 32 * l32;
            f32x4 q[8]; float mx = 0.f;
#pragma unroll
            for (int k = 0; k < 8; ++k) { q[k] = *(const f32x4*)(src + 4 * k);
#pragma unroll
                for (int i = 0; i < 4; ++i) mx = fmaxf(mx, fabsf(q[k][i])); }
#pragma unroll
            for (int o = 1; o < 32; o <<= 1) mx = fmaxf(mx, __shfl_xor(mx, o));
            const float sc = mx > 0.f ? 6.f / mx : 1.f, isc = mx > 0.f ? mx * (1.f / 6.f) : 1.f;
            u32x4 w;
#pragma unroll
            for (int d = 0; d < 4; ++d) { unsigned t_ = 0u;
                t_ = __builtin_amdgcn_cvt_scalef32_pk_fp4_f32(t_, q[2 * d][0] * sc, q[2 * d][1] * sc, 1.0f, 0);
                t_ = __builtin_amdgcn_cvt_scalef32_pk_fp4_f32(t_, q[2 * d][2] * sc, q[2 * d][3] * sc, 1.0f, 1);
                t_ = __builtin_amdgcn_cvt_scalef32_pk_fp4_f32(t_, q[2 * d + 1][0] * sc, q[2 * d + 1][1] * sc, 1.0f, 2);
                t_ = __builtin_amdgcn_cvt_scalef32_pk_fp4_f32(t_, q[2 * d + 1][2] * sc, q[2 * d + 1][3] * sc, 1.0f, 3);
                w[d] = t_; }
            *(u32x4*)((isv ? V8 : U6) + (size_t)e * 512 + 16 * l32) = w;
            if (l32 == 0) (isv ? SV : SU)[e] = isc;
        }
    }
    {
        bf16_t* SK = (bf16_t*)(p.ws + WS_SK); const size_t n8 = 16 * 128 * 128 / 8;
        for (size_t i = gt; i < n8; i += ng) { const float* src = p.sub_keys + i * 8; const f32x4 a = *(const f32x4*)src, b = *(const f32x4*)(src + 4);
            u32x4 w; w.x = cvtpk(a[0], a[1]); w.y = cvtpk(a[2], a[3]); w.z = cvtpk(b[0], b[1]); w.w = cvtpk(b[2], b[3]); *(u32x4*)(SK + i * 8) = w; }
    }
    {
        bf16_t* WTI = (bf16_t*)(p.ws + WS_WTIN); bf16_t* WTO = (bf16_t*)(p.ws + WS_WTOUT); bf16_t* WTQ = (bf16_t*)(p.ws + WS_WTQ);
        const size_t nI = 0  , nO = (size_t)1024 * 128, nQ = (size_t)2048 * 128;
        for (size_t i0_ = gt; i0_ < nI + nO + nQ; i0_ += 3 * ng) {
            float v[3][8]; bf16_t* dst[3];
#pragma unroll
            for (int q = 0; q < 3; ++q) {
                const size_t i = i0_ + (size_t)q * ng; const bool ok = i < nI + nO + nQ; const size_t ii = ok ? i : gt;
                const float* W; bf16_t* WT; int N, pitch, n, kc, sc_;
                if (ii < nI) { N = NPROJ; pitch = INW; W = p.w_in; WT = WTI; n = (int)(ii % N); kc = (int)(ii / N); sc_ = n < 1536 ? n : n + 8; }
                else if (ii < nI + nO) { const size_t j = ii - nI; N = 1024; pitch = 1024; W = p.w_out; WT = WTO; n = (int)(j % N); kc = (int)(j / N); sc_ = n; }
                else { const size_t j = ii - nI - nO; N = 2048; pitch = 2048; W = p.w_query; WT = WTQ; n = (int)(j % N); kc = (int)(j / N); sc_ = n; }
#pragma unroll
                for (int j = 0; j < 8; ++j) v[q][j] = W[(size_t)(kc * 8 + j) * pitch + sc_];
                dst[q] = ok ? WT + (size_t)n * 1024 + kc * 8 : nullptr;
            }
#pragma unroll
            for (int q = 0; q < 3; ++q) if (dst[q]) { u32x4 w; w.x = cvtpk(v[q][0], v[q][1]); w.y = cvtpk(v[q][2], v[q][3]); w.z = cvtpk(v[q][4], v[q][5]); w.w = cvtpk(v[q][6], v[q][7]); *(u32x4*)dst[q] = w; }
        }
    }
    {
        unsigned* CMAX = (unsigned*)(p.ws + WS_CMAX);
        const int lane = tid & 63, gw = blockIdx.x * NWAVES + (tid >> 6), ngw = gridDim.x * NWAVES;
        for (int it = gw; it < (NPROJ / 64) * 64; it += ngw) { const int cg = it % (NPROJ / 64), ks = it / (NPROJ / 64); const int n = 64 * cg + lane, sc_ = n < 1536 ? n : n + 8;
            float m = 0.f;
#pragma unroll
            for (int k = 0; k < 16; ++k) m = fmaxf(m, fabsf(p.w_in[(size_t)(ks * 16 + k) * INW + sc_]));
            atomicMax(&CMAX[n], __float_as_uint(m)); }
    }
    {
        float* WF = (float*)(p.ws + WS_WF);
        for (size_t i = gt; i < 8 * 1024; i += ng) { const int hd = (int)(i & 7), k = (int)(i >> 3); WF[hd * 1024 + k] = p.w_in[(size_t)k * INW + 1536 + hd]; }
    }
}

__device__ __forceinline__ void ld16(const float* rowp, int lane, float (&v)[16]) {
    const f32x4 a = *(const f32x4*)(rowp + 8 * lane), b = *(const f32x4*)(rowp + 8 * lane + 4), c = *(const f32x4*)(rowp + 512 + 8 * lane), d = *(const f32x4*)(rowp + 512 + 8 * lane + 4);
#pragma unroll
    for (int i = 0; i < 4; ++i) { v[i] = a[i]; v[4 + i] = b[i]; v[8 + i] = c[i]; v[12 + i] = d[i]; }
}
__device__ __forceinline__ void st16_bf16(bf16_t* rowp, int lane, const float (&v)[16]) {
    u32x4 w0, w1; w0.x = cvtpk(v[0], v[1]); w0.y = cvtpk(v[2], v[3]); w0.z = cvtpk(v[4], v[5]); w0.w = cvtpk(v[6], v[7]);
    w1.x = cvtpk(v[8], v[9]); w1.y = cvtpk(v[10], v[11]); w1.z = cvtpk(v[12], v[13]); w1.w = cvtpk(v[14], v[15]);
    *(u32x4*)(rowp + 8 * lane) = w0; *(u32x4*)(rowp + 512 + 8 * lane) = w1;
}
__device__ __forceinline__ void ld16_bf16(const bf16_t* rowp, int lane, float (&v)[16]) {
    const u32x4 w0 = *(const u32x4*)(rowp + 8 * lane), w1 = *(const u32x4*)(rowp + 512 + 8 * lane);
    v[0] = bflo(w0.x); v[1] = bfhi(w0.x); v[2] = bflo(w0.y); v[3] = bfhi(w0.y); v[4] = bflo(w0.z); v[5] = bfhi(w0.z); v[6] = bflo(w0.w); v[7] = bfhi(w0.w);
    v[8] = bflo(w1.x); v[9] = bfhi(w1.x); v[10] = bflo(w1.y); v[11] = bfhi(w1.y); v[12] = bflo(w1.z); v[13] = bfhi(w1.z); v[14] = bflo(w1.w); v[15] = bfhi(w1.w);
}
__device__ __forceinline__ void st16(float* rowp, int lane, const float (&v)[16]) {
    *(f32x4*)(rowp + 8 * lane) = (f32x4){v[0], v[1], v[2], v[3]}; *(f32x4*)(rowp + 8 * lane + 4) = (f32x4){v[4], v[5], v[6], v[7]};
    *(f32x4*)(rowp + 512 + 8 * lane) = (f32x4){v[8], v[9], v[10], v[11]}; *(f32x4*)(rowp + 512 + 8 * lane + 4) = (f32x4){v[12], v[13], v[14], v[15]};
}

#define DPP_ADDF(v, ctrl) v += __uint_as_float((unsigned)__builtin_amdgcn_update_dpp(0, (int)__float_as_uint(v), ctrl, 0xf, 0xf, true))
__device__ __forceinline__ float wave_sum_dpp(float v) {
    DPP_ADDF(v, 0xB1); DPP_ADDF(v, 0x4E); DPP_ADDF(v, 0x141); DPP_ADDF(v, 0x140);
    const float a = __uint_as_float((unsigned)__builtin_amdgcn_readlane((int)__float_as_uint(v), 0)), b = __uint_as_float((unsigned)__builtin_amdgcn_readlane((int)__float_as_uint(v), 16));
    const float c = __uint_as_float((unsigned)__builtin_amdgcn_readlane((int)__float_as_uint(v), 32)), d = __uint_as_float((unsigned)__builtin_amdgcn_readlane((int)__float_as_uint(v), 48));
    return (a + b) + (c + d);
}
__device__ __forceinline__ void phase1(const Params& p, LAS unsigned char* lds) {
    const int tid_ = fresh_tid(); const int lane = tid_ & 63, wid = tid_ >> 6;
    const int gw = blockIdx.x * NWAVES + wid, ngw = gridDim.x * NWAVES;
    const float* mod = (const float*)(p.ws + WS_MOD); const float* WF = (const float*)(p.ws + WS_WF);
    bf16_t* H = (bf16_t*)(p.ws + WS_H); float* LS = (float*)(p.ws + WS_LS);
    LAS float* wfl = (LAS float*)lds;
    for (int i = tid_; i < 8 * DM / 4; i += NTHREADS) *(LAS f32x4*)(wfl + 4 * i) = *(const f32x4*)(WF + 4 * i);
    __syncthreads();
    float g[16]; ld16(p.g_pre_mix, lane, g);
    const float bfg = (lane & 7) == 0 ? p.b_fgate[lane >> 3] : 0.f;
    for (int t0 = gw * 16; t0 < T; t0 += ngw * 16) {
        const int b = t0 / SEQ;
        float A[16], sh[16];
        { float sc[16]; ld16(mod + b * NMOD, lane, sh); ld16(mod + b * NMOD + DM, lane, sc);
#pragma unroll
          for (int i = 0; i < 16; ++i) A[i] = g[i] * (1.f + sc[i]); }
        float xn[16]; ld16(p.x + (size_t)t0 * DM, lane, xn);
#pragma unroll 1
        for (int r = 0; r < 16; ++r) {
            const int t = t0 + r;
            float xv[16];
#pragma unroll
            for (int i = 0; i < 16; ++i) xv[i] = xn[i];
            if (r + 1 < 16) ld16(p.x + (size_t)(t + 1) * DM, lane, xn);
            float ss = 0.f;
#pragma unroll
            for (int i = 0; i < 16; ++i) ss += xv[i] * xv[i];
            const float rstd = rsqrtf(wave_sum_dpp(ss) * (1.f / DM) + RMS_EPS);
            float h[16];
#pragma unroll
            for (int i = 0; i < 16; ++i) h[i] = xv[i] * rstd * A[i] + sh[i];
            { float hm = 0.f;
#pragma unroll
              for (int i = 0; i < 16; ++i) hm = fmaxf(hm, fabsf(h[i]));
#pragma unroll
              for (int o = 1; o < 64; o <<= 1) hm = fmaxf(hm, __shfl_xor(hm, o));
              int e8 = hm > 0.f ? (int)floorf(__log2f(224.f / hm)) : 0; e8 = e8 < -100 ? -100 : (e8 > 100 ? 100 : e8);
              const float q8 = __uint_as_float((unsigned)(127 + e8) << 23);
              unsigned w4[4];
#pragma unroll
              for (int c = 0; c < 4; ++c) { int t_ = __builtin_amdgcn_cvt_pk_fp8_f32(h[4 * c] * q8, h[4 * c + 1] * q8, 0, false); t_ = __builtin_amdgcn_cvt_pk_fp8_f32(h[4 * c + 2] * q8, h[4 * c + 3] * q8, t_, true); w4[c] = (unsigned)t_; }
              unsigned char* hrow8 = (unsigned char*)H + (size_t)t * DM;
              *(u32x2*)(hrow8 + 8 * lane) = (u32x2){w4[0], w4[1]}; *(u32x2*)(hrow8 + 512 + 8 * lane) = (u32x2){w4[2], w4[3]};
              if (lane == 0) (p.ws + WS_HMAX)[t] = (unsigned char)(127 - e8); }
            float s[8];
#pragma unroll
            for (int hd = 0; hd < 8; ++hd) {
                const LAS float* wr = wfl + hd * DM;
                const f32x4 w0 = *(const LAS f32x4*)(wr + 8 * lane), w1 = *(const LAS f32x4*)(wr + 8 * lane + 4), w2 = *(const LAS f32x4*)(wr + 512 + 8 * lane), w3 = *(const LAS f32x4*)(wr + 512 + 8 * lane + 4);
                float a = 0.f;
#pragma unroll
                for (int i = 0; i < 4; ++i) a += h[i] * w0[i] + h[4 + i] * w1[i] + h[8 + i] * w2[i] + h[12 + i] * w3[i];
                s[hd] = a;
            }
            const bool b32 = (lane & 32) != 0, b16 = (lane & 16) != 0, b8 = (lane & 8) != 0;
            float r4[4], r2[2], v;
#pragma unroll
            for (int k = 0; k < 4; ++k) { const float mine = b32 ? s[k + 4] : s[k], send = b32 ? s[k] : s[k + 4]; r4[k] = mine + __shfl_xor(send, 32); }
#pragma unroll
            for (int k = 0; k < 2; ++k) { const float mine = b16 ? r4[k + 2] : r4[k], send = b16 ? r4[k] : r4[k + 2]; r2[k] = mine + __shfl_xor(send, 16); }
            { const float mine = b8 ? r2[1] : r2[0], send = b8 ? r2[0] : r2[1]; v = mine + __shfl_xor(send, 8); }
            v += __shfl_xor(v, 4); v += __shfl_xor(v, 2); v += __shfl_xor(v, 1);
            if ((lane & 7) == 0) { const float z = v + bfg;
                const float lsg = z >= 0.f ? -log1pf(__expf(-z)) : z - log1pf(__expf(z));
                LS[(size_t)t * 8 + (lane >> 3)] = lsg; }
        }
    }
    {
        unsigned char* WT8 = p.ws + WS_WTIN; const float* CMAX = (const float*)(p.ws + WS_CMAX);
        const size_t gt = (size_t)blockIdx.x * NTHREADS + tid_, ng = (size_t)gridDim.x * NTHREADS, nI = (size_t)NPROJ * 128;
        for (size_t i = gt; i < nI; i += ng) {
            const int n = (int)(i % NPROJ), kc = (int)(i / NPROJ), sc_ = n < 1536 ? n : n + 8;
            float v[8];
#pragma unroll
            for (int j = 0; j < 8; ++j) v[j] = p.w_in[(size_t)(kc * 8 + j) * INW + sc_];
            const float cm = CMAX[n];
            int e8 = cm > 0.f ? (int)floorf(__log2f(224.f / cm)) : 0; e8 = e8 < -100 ? -100 : (e8 > 100 ? 100 : e8);
            const float q8 = __uint_as_float((unsigned)(127 + e8) << 23);
            if (kc == 0) (p.ws + WS_CMAX + 12288)[n] = (unsigned char)(127 - e8);
            int t0_ = __builtin_amdgcn_cvt_pk_fp8_f32(v[0] * q8, v[1] * q8, 0, false); t0_ = __builtin_amdgcn_cvt_pk_fp8_f32(v[2] * q8, v[3] * q8, t0_, true);
            int t1_ = __builtin_amdgcn_cvt_pk_fp8_f32(v[4] * q8, v[5] * q8, 0, false); t1_ = __builtin_amdgcn_cvt_pk_fp8_f32(v[6] * q8, v[7] * q8, t1_, true);
            *(u32x2*)(WT8 + (size_t)n * 1024 + kc * 8) = (u32x2){(unsigned)t0_, (unsigned)t1_};
        }
    }
    __syncthreads();
}

__device__ __forceinline__ void scan_kb(const Params& p, LAS unsigned char* lds) {
    const int first = (int)gridDim.x >= BATCH * 8 ? (int)gridDim.x - BATCH * 8 : 0;
    for (int sb = (int)blockIdx.x - first; sb >= 0 && sb < BATCH * 8; sb += (int)gridDim.x) {
        const int tid = fresh_tid(), lane = tid & 63, wid = tid >> 6, b = sb >> 3, hd = sb & 7;
        const float* LS = (const float*)(p.ws + WS_LS) + (size_t)b * SEQ * 8 + hd; float* KB = (float*)(p.ws + WS_KB) + (size_t)sb * SEQ;
        LAS double* wtot = (LAS double*)lds;
        double loc[16]; double s = 0.0;
#pragma unroll
        for (int i = 0; i < 16; ++i) { s += (double)LS[(size_t)(tid * 16 + i) * 8]; loc[i] = s; }
        double v = s;
#pragma unroll
        for (int o = 1; o < 64; o <<= 1) { const double u = __shfl_up(v, o); if (lane >= o) v += u; }
        __syncthreads();
        if (lane == 63) wtot[wid] = v;
        __syncthreads();
        double base = v - s;
        for (int w = 0; w < wid; ++w) base += wtot[w];
#pragma unroll
        for (int i = 0; i < 16; ++i) KB[tid * 16 + i] = (float)(-(base + loc[i]) * (double)LOG2E);
        __syncthreads();
    }
}

__device__ __forceinline__ void stage_kv_tile(LAS unsigned char* kimg, LAS unsigned char* vimg, const bf16_t* Kg, const bf16_t* Vg, long row0, long rowmin, int pitch, int wid, int lane) {
    long rk = row0 + lane; if (rk < rowmin) rk = rowmin;
    const bf16_t* ks = Kg + rk * pitch + wid * 8;
    __builtin_amdgcn_global_load_lds((const unsigned*)ks, (LAS unsigned*)(kimg + wid * 1024), 16, 0, 0);
    long rv = row0 + 16 * (wid & 3) + (lane >> 2); if (rv < rowmin) rv = rowmin;
    const bf16_t* vs = Vg + rv * pitch + (wid >> 2) * 32 + (lane & 3) * 8;
    __builtin_amdgcn_global_load_lds((const unsigned*)vs, (LAS unsigned*)(vimg + wid * 1024), 16, 0, 0);
}
__device__ __forceinline__ s16x4 vtr(const LAS unsigned char* ptr) {
    typedef short v4i16_t __attribute__((ext_vector_type(4)));
    return __builtin_bit_cast(s16x4, __builtin_amdgcn_ds_read_tr16_b64_v4i16((LAS v4i16_t*)ptr));
}
__device__ __forceinline__ void qk_tile(f32x16& p0, f32x16& p1, const LAS unsigned char* kimg, const bf16x8 (&qr)[4], int r32, int hi) {
    const LAS unsigned char* kb = kimg + hi * 1024 + r32 * 16;
    p0 = (f32x16){}; p1 = (f32x16){};
#pragma unroll
    for (int d0 = 0; d0 < 4; ++d0) {
        const bf16x8 b0 = *(const LAS bf16x8*)(kb + d0 * 2048), b1 = *(const LAS bf16x8*)(kb + d0 * 2048 + 512);
        p0 = __builtin_amdgcn_mfma_f32_32x32x16_bf16(b0, qr[d0], p0, 0, 0, 0);
        p1 = __builtin_amdgcn_mfma_f32_32x32x16_bf16(b1, qr[d0], p1, 0, 0, 0);
    }
}
__device__ __forceinline__ void softmax_pv(f32x16& p0, f32x16& p1, const LAS unsigned char* vimg, f32x16& o0, f32x16& o1, float& m, float& l, int lane, int hi) {
    float rm = p0[0];
#pragma unroll
    for (int r = 1; r < 16; ++r) rm = fmaxf(rm, p0[r]);
#pragma unroll
    for (int r = 0; r < 16; ++r) rm = fmaxf(rm, p1[r]);
    rm = fmaxf(rm, __shfl_xor(rm, 32));
    const float mn = fmaxf(m, rm);
    const float alpha = __builtin_amdgcn_exp2f(m - mn);
    m = mn;
    float ps = 0.f;
#pragma unroll
    for (int r = 0; r < 16; ++r) { p0[r] = __builtin_amdgcn_exp2f(p0[r] - mn); ps += p0[r]; }
#pragma unroll
    for (int r = 0; r < 16; ++r) { p1[r] = __builtin_amdgcn_exp2f(p1[r] - mn); ps += p1[r]; }
    l = l * alpha + ps;
    if (!__all(alpha == 1.0f)) {
#pragma unroll
        for (int r = 0; r < 16; ++r) { const float a = __shfl(alpha, crow(r, hi)); o0[r] *= a; o1[r] *= a; }
    }
    u32x4 pw[4];
    pw[0] = (u32x4){cvtpk(p0[0], p0[1]), cvtpk(p0[2], p0[3]), cvtpk(p0[4], p0[5]), cvtpk(p0[6], p0[7])};
    pw[1] = (u32x4){cvtpk(p0[8], p0[9]), cvtpk(p0[10], p0[11]), cvtpk(p0[12], p0[13]), cvtpk(p0[14], p0[15])};
    pw[2] = (u32x4){cvtpk(p1[0], p1[1]), cvtpk(p1[2], p1[3]), cvtpk(p1[4], p1[5]), cvtpk(p1[6], p1[7])};
    pw[3] = (u32x4){cvtpk(p1[8], p1[9]), cvtpk(p1[10], p1[11]), cvtpk(p1[12], p1[13]), cvtpk(p1[14], p1[15])};
    const LAS unsigned char* vb = vimg + ((lane >> 4) & 1) * 32 + (lane & 3) * 8 + (4 * hi + ((lane & 15) >> 2)) * 64;
#pragma unroll
    for (int ks = 0; ks < 4; ++ks) {
        const bf16x8 pa = __builtin_bit_cast(bf16x8, pw[ks]);
        { const s16x4 lo = vtr(vb + ks * 1024), hh = vtr(vb + ks * 1024 + 512);
          const bf16x8 vf = (bf16x8){lo[0], lo[1], lo[2], lo[3], hh[0], hh[1], hh[2], hh[3]};
          o0 = __builtin_amdgcn_mfma_f32_32x32x16_bf16(pa, vf, o0, 0, 0, 0); }
        { const s16x4 lo = vtr(vb + 4096 + ks * 1024), hh = vtr(vb + 4096 + ks * 1024 + 512);
          const bf16x8 vf = (bf16x8){lo[0], lo[1], lo[2], lo[3], hh[0], hh[1], hh[2], hh[3]};
          o1 = __builtin_amdgcn_mfma_f32_32x32x16_bf16(pa, vf, o1, 0, 0, 0); }
    }
}
__device__ __forceinline__ void store_o(bf16_t* Obase  , int pitch, const f32x16& o0, const f32x16& o1, float linv, int r32, int hi) {
#pragma unroll
    for (int r = 0; r < 16; ++r) { const int q = crow(r, hi); const float li = __shfl(linv, q);
        bf16_t* rp = Obase + (size_t)q * pitch;
        rp[r32] = (bf16_t)(cvtpk(o0[r] * li, 0.f) & 0xffffu); rp[32 + r32] = (bf16_t)(cvtpk(o1[r] * li, 0.f) & 0xffffu); }
}

constexpr float FOX_THR = 30.f;
__device__ __forceinline__ void glds16(const void* gsrc, unsigned lds_dst) {
    unsigned keep;
    asm volatile("s_mov_b32 %0, m0\n\ts_mov_b32 m0, %2\n\ts_nop 0\n\tglobal_load_lds_dwordx4 %1, off\n\ts_mov_b32 m0, %0" : "=&s"(keep) : "v"(gsrc), "s"(lds_dst) : "memory");
}
__device__ __forceinline__ unsigned f2ord(float f) { const unsigned b = __float_as_uint(f); return (b & 0x80000000u) ? ~b : (b | 0x80000000u); }
__device__ __forceinline__ float ord2f(unsigned u) { return __uint_as_float((u & 0x80000000u) ? (u & 0x7fffffffu) : ~u); }
__device__ __forceinline__ void fox_prepass(const Params& p) {
    const int tid = fresh_tid(), lane = tid & 63, gw = blockIdx.x * NWAVES + (tid >> 6), ngw = gridDim.x * NWAVES;
    const bf16_t* PROJ = (const bf16_t*)(p.ws + WS_PROJ); float* KT = (float*)(p.ws + WS_KT);
    for (int it = gw; it < 32 * 128; it += ngw) {
        const int bh = it >> 7, j = it & 127, b = bh >> 3, h = bh & 7;
        const bf16_t* kr = PROJ + (size_t)((long)b * SEQ + 64 * j + lane) * NPROJ + 512 + h * 64;
        float ss = 0.f;
#pragma unroll
        for (int c = 0; c < 8; ++c) { const u32x4 w = *(const u32x4*)(kr + 8 * c);
            ss += bflo(w.x) * bflo(w.x) + bfhi(w.x) * bfhi(w.x) + bflo(w.y) * bflo(w.y) + bfhi(w.y) * bfhi(w.y) + bflo(w.z) * bflo(w.z) + bfhi(w.z) * bfhi(w.z) + bflo(w.w) * bflo(w.w) + bfhi(w.w) * bfhi(w.w); }
#pragma unroll
        for (int o = 1; o < 64; o <<= 1) ss = fmaxf(ss, __shfl_xor(ss, o));
        if (lane == 0) KT[it] = ss;
    }
}
constexpr int FOX_BUF = 16384, FOX_NBUF = 4, FOX_KB_OFF = FOX_NBUF * FOX_BUF, FOX_CTL_OFF = FOX_KB_OFF + 32768;
#define FOX_WAIT_BAR(N) asm volatile("s_waitcnt vmcnt(" #N ")\n\ts_barrier" ::: "memory")
__device__ __forceinline__ void fox_stage(unsigned ldsbase, int slot, const bf16_t* Kg, const bf16_t* Vg, long row0, int wid, int lane) {
    const bf16_t* ks = Kg + (row0 + lane) * NPROJ + wid * 8;
    const bf16_t* vs = Vg + (row0 + 16 * (wid & 3) + (lane >> 2)) * NPROJ + (wid >> 2) * 32 + (lane & 3) * 8;
    const unsigned dst = (unsigned)__builtin_amdgcn_readfirstlane((int)(ldsbase + (unsigned)slot * FOX_BUF + (unsigned)wid * 1024u));
    glds16(ks, dst); glds16(vs, dst + 8192u);
}
__device__ __forceinline__ void fox_unit(const Params& p, LAS unsigned char* lds, int b, int h, int qb) {
    const int tid = fresh_tid(), lane = tid & 63, wid = __builtin_amdgcn_readfirstlane(tid >> 6), r32 = lane & 31, hi = lane >> 5;
    const bf16_t* PROJ = (const bf16_t*)(p.ws + WS_PROJ);
    bf16_t* ATT = (bf16_t*)(p.ws + WS_ATT);
    const float* KB = (const float*)(p.ws + WS_KB) + (size_t)(b * 8 + h) * SEQ;
    const float* KT = (const float*)(p.ws + WS_KT) + (b * 8 + h) * 128;
    const long rowb = (long)b * SEQ; const int q0 = qb * 256;
    const bf16_t* Kg = PROJ + 512 + h * 64; const bf16_t* Vg = PROJ + 1024 + h * 64;
    LAS float* kbl = (LAS float*)(lds + FOX_KB_OFF); LAS unsigned* ctl = (LAS unsigned*)(lds + FOX_CTL_OFF);
    const unsigned ldsbase = (unsigned)(uintptr_t)lds;
    const int qw = q0 + 32 * wid;
    const int NT = (q0 + 256) / 64;
    bf16x8 qr[4]; float qn2 = 0.f, xs = 0.f;
#pragma unroll
    for (int d0 = 0; d0 < 4; ++d0) {
        qr[d0] = *(const bf16x8*)(PROJ + (size_t)(rowb + qw + r32) * NPROJ + h * 64 + d0 * 16 + hi * 8);
        const bf16x8 kk = *(const bf16x8*)(PROJ + (size_t)(rowb + qw + r32) * NPROJ + 512 + h * 64 + d0 * 16 + hi * 8);
#pragma unroll
        for (int j = 0; j < 8; ++j) { const float v = __uint_as_float(((unsigned)(unsigned short)qr[d0][j]) << 16), kv = __uint_as_float(((unsigned)(unsigned short)kk[j]) << 16); qn2 += v * v; xs += v * kv; }
    }
    qn2 += __shfl_xor(qn2, 32); xs += __shfl_xor(xs, 32);
    const float kbq = KB[qw + r32];
    float kt_ = 0.f, kbe_ = 0.f;
    if (tid < NT) { kt_ = KT[tid]; kbe_ = KB[64 * tid + 63]; }
    __syncthreads();
    if (tid == 0) { ctl[0] = 0u; ctl[1] = (unsigned)(NT - 4); ctl[2] = 0u; ctl[3] = 0xffffffffu; }
    __syncthreads();
    { float qm = qn2, sm = xs + kbq;
#pragma unroll
      for (int o = 1; o < 32; o <<= 1) { qm = fmaxf(qm, __shfl_xor(qm, o)); sm = fminf(sm, __shfl_xor(sm, o)); }
      if (lane == 0) { atomicMax((unsigned*)&ctl[0], __float_as_uint(qm)); atomicMin((unsigned*)&ctl[3], f2ord(sm)); } }
    __syncthreads();
    const float qmax2 = __uint_as_float(ctl[0]);
    if (tid < NT - 4) {
        const float smin = ord2f(ctl[3]);
        const float ub = sqrtf(qmax2 * kt_) * 1.0001f + kbe_;
        if (!(ub + FOX_THR <= smin - 1e-3f * fabsf(smin))) atomicMin((unsigned*)&ctl[1], (unsigned)tid);
    }
    __syncthreads();
    const int jstart = (int)ctl[1];
    __builtin_amdgcn_s_waitcnt(0);
    fox_stage(ldsbase, 0, Kg, Vg, rowb + 64 * jstart, wid, lane);
    if (jstart + 1 < NT) fox_stage(ldsbase, 1, Kg, Vg, rowb + 64 * (jstart + 1), wid, lane);
    if (jstart + 2 < NT) fox_stage(ldsbase, 2, Kg, Vg, rowb + 64 * (jstart + 2), wid, lane);
    if (tid >= jstart && tid < NT) atomicMax((unsigned*)&ctl[2], __float_as_uint(kt_));
    for (int i = 64 * jstart + tid; i < 64 * NT; i += NTHREADS) kbl[i - 64 * jstart] = KB[i];
    __syncthreads();
    const float kmaxu = sqrtf(__uint_as_float(ctl[2]));
    const float ref = sqrtf(qn2) * kmaxu * 1.0001f + kbq;
    f32x16 o0 = (f32x16){}, o1 = (f32x16){}; float l = 0.f;
    for (int jt = jstart; jt < NT; ++jt) {
        if (jt + 2 < NT) FOX_WAIT_BAR(4); else if (jt + 1 < NT) FOX_WAIT_BAR(2); else FOX_WAIT_BAR(0);
        if (jt + 3 < NT) fox_stage(ldsbase, (jt + 3 - jstart) & 3, Kg, Vg, rowb + 64 * (jt + 3), wid, lane);
        LAS unsigned char* buf = lds + ((jt - jstart) & 3) * FOX_BUF;
        if (64 * jt <= qw + 31) {
            const LAS float* kbt = kbl + 64 * (jt - jstart);
            f32x16 p0, p1;
#pragma unroll
            for (int g = 0; g < 4; ++g) {
                const f32x4 k0 = *(const LAS f32x4*)(kbt + 8 * g + 4 * hi), k1 = *(const LAS f32x4*)(kbt + 32 + 8 * g + 4 * hi);
#pragma unroll
                for (int i = 0; i < 4; ++i) { p0[4 * g + i] = k0[i] - ref; p1[4 * g + i] = k1[i] - ref; }
            }
            { const LAS unsigned char* kb_ = buf + hi * 1024 + r32 * 16;
#pragma unroll
              for (int d0 = 0; d0 < 4; ++d0) {
                  const bf16x8 b0 = *(const LAS bf16x8*)(kb_ + d0 * 2048), b1 = *(const LAS bf16x8*)(kb_ + d0 * 2048 + 512);
                  p0 = __builtin_amdgcn_mfma_f32_32x32x16_bf16(b0, qr[d0], p0, 0, 0, 0);
                  p1 = __builtin_amdgcn_mfma_f32_32x32x16_bf16(b1, qr[d0], p1, 0, 0, 0);
              } }
            float ps = 0.f;
            if (64 * jt + 63 > qw) {
                const int tq = qw + r32;
#pragma unroll
                for (int r = 0; r < 16; ++r) { const int s_ = 64 * jt + crow(r, hi);
                    p0[r] = (s_ > tq) ? 0.f : __builtin_amdgcn_exp2f(p0[r]); p1[r] = (s_ + 32 > tq) ? 0.f : __builtin_amdgcn_exp2f(p1[r]); ps += p0[r] + p1[r]; }
            } else {
#pragma unroll
                for (int r = 0; r < 16; ++r) { p0[r] = __builtin_amdgcn_exp2f(p0[r]); p1[r] = __builtin_amdgcn_exp2f(p1[r]); ps += p0[r] + p1[r]; }
            }
            l += ps;
            u32x4 pw[4];
            pw[0] = (u32x4){cvtpk(p0[0], p0[1]), cvtpk(p0[2], p0[3]), cvtpk(p0[4], p0[5]), cvtpk(p0[6], p0[7])};
            pw[1] = (u32x4){cvtpk(p0[8], p0[9]), cvtpk(p0[10], p0[11]), cvtpk(p0[12], p0[13]), cvtpk(p0[14], p0[15])};
            pw[2] = (u32x4){cvtpk(p1[0], p1[1]), cvtpk(p1[2], p1[3]), cvtpk(p1[4], p1[5]), cvtpk(p1[6], p1[7])};
            pw[3] = (u32x4){cvtpk(p1[8], p1[9]), cvtpk(p1[10], p1[11]), cvtpk(p1[12], p1[13]), cvtpk(p1[14], p1[15])};
            const LAS unsigned char* vb = buf + 8192 + ((lane >> 4) & 1) * 32 + (lane & 3) * 8 + (4 * hi + ((lane & 15) >> 2)) * 64;
#pragma unroll
            for (int ks = 0; ks < 4; ++ks) {
                const bf16x8 pa = __builtin_bit_cast(bf16x8, pw[ks]);
                { const s16x4 lo = vtr(vb + ks * 1024), hh = vtr(vb + ks * 1024 + 512);
                  const bf16x8 vf = (bf16x8){lo[0], lo[1], lo[2], lo[3], hh[0], hh[1], hh[2], hh[3]};
                  o0 = __builtin_amdgcn_mfma_f32_32x32x16_bf16(pa, vf, o0, 0, 0, 0); }
                { const s16x4 lo = vtr(vb + 4096 + ks * 1024), hh = vtr(vb + 4096 + ks * 1024 + 512);
                  const bf16x8 vf = (bf16x8){lo[0], lo[1], lo[2], lo[3], hh[0], hh[1], hh[2], hh[3]};
                  o1 = __builtin_amdgcn_mfma_f32_32x32x16_bf16(pa, vf, o1, 0, 0, 0); }
            }
        }
    }
    const float lt = l + __shfl_xor(l, 32);
    const float linv = 1.f / lt;
    __syncthreads();
    {
        LAS bf16_t* stg = (LAS bf16_t*)(lds + wid * 4096);
#pragma unroll
        for (int r = 0; r < 16; ++r) { const int q = crow(r, hi); const float li = __shfl(linv, q);
            stg[q * 64 + r32] = (bf16_t)(cvtpk(o0[r] * li, 0.f) & 0xffffu); stg[q * 64 + 32 + r32] = (bf16_t)(cvtpk(o1[r] * li, 0.f) & 0xffffu); }
        bf16_t* Ow = ATT + (size_t)(rowb + qw) * DM + h * 64;
#pragma unroll
        for (int i = 0; i < 4; ++i) { const int row = i * 8 + (lane >> 3), ch = lane & 7; const u32x4 v = *(const LAS u32x4*)(stg + row * 64 + ch * 8); *(u32x4*)(Ow + (size_t)row * DM + ch * 8) = v; }
    }
}
__device__ __forceinline__ void phase_fox(const Params& p, LAS unsigned char* lds) {
    if ((gridDim.x & 7) == 0) {
        unsigned* qw_ = (unsigned*)(p.ws + WS_BAR) + 16 * (blockIdx.x & 7);
        LAS int* uq = (LAS int*)(lds + FOX_CTL_OFF + 64);
        const int x = blockIdx.x & 7;
        for (;;) {
            __syncthreads();
            if (threadIdx.x == 0) *uq = (int)atomicAdd(qw_, 1u);
            __syncthreads();
            const int u = *uq;
            if (u >= 128) break;
            const int i = u & 3;
            fox_unit(p, lds, i, (x - i) & 7, 31 - (u >> 2));
        }
    } else {
        for (int u = blockIdx.x; u < 1024; u += gridDim.x) fox_unit(p, lds, (u & 31) >> 3, u & 7, 31 - (u >> 5));
    }
}

__device__ __forceinline__ void swa_unit(const Params& p, LAS unsigned char* lds, int b, int kvh, int qblk) {
    const int tid = fresh_tid(), lane = tid & 63, wid = __builtin_amdgcn_readfirstlane(tid >> 6), r32 = lane & 31, hi = lane >> 5;
    const bf16_t* PROJ = (const bf16_t*)(p.ws + WS_PROJ);
    bf16_t* ATT = (bf16_t*)(p.ws + WS_ATT);
    const long rowb = (long)b * SEQ; const int q0 = qblk * 128;
    const bf16_t* Kg = PROJ + 2048 + kvh * 64; const bf16_t* Vg = PROJ + 2176 + kvh * 64;
    __syncthreads();
#pragma unroll
    for (int j = 0; j < 4; ++j) stage_kv_tile(lds + j * 16384, lds + j * 16384 + 8192, Kg, Vg, rowb + q0 - 128 + 64 * j, rowb, NPROJ, wid, lane);
    __syncthreads();
#pragma unroll 1
    for (int i = 0; i < 2; ++i) {
        const int task = wid * 2 + i, g = task >> 2, sub = task & 3, hq = kvh * 4 + g;
        const int qw = q0 + 32 * sub;
        const float slope = exp2f(-(float)(hq + 1)) * LOG2E;
        bf16x8 qr[4];
#pragma unroll
        for (int d0 = 0; d0 < 4; ++d0) qr[d0] = *(const bf16x8*)(PROJ + (size_t)(rowb + qw + r32) * NPROJ + 1536 + hq * 64 + d0 * 16 + hi * 8);
        f32x16 o0 = (f32x16){}, o1 = (f32x16){}; float m = NEGBIG, l = 0.f;
        const int j0 = (32 * sub + 1) >> 6, j1 = (32 * sub + 159) >> 6;
        for (int j = j0; j <= j1; ++j) {
            f32x16 p0, p1; qk_tile(p0, p1, lds + j * 16384, qr, r32, hi);
            const int tq = 128 + 32 * sub + r32;
#pragma unroll
            for (int r = 0; r < 16; ++r) {
                const int s0 = 64 * j + crow(r, hi), s1 = s0 + 32;
                const int d0 = tq - s0, d1 = tq - s1;
                const bool v0 = (d0 >= 0) && (d0 < 128) && (q0 - 128 + s0 >= 0), v1 = (d1 >= 0) && (d1 < 128) && (q0 - 128 + s1 >= 0);
                p0[r] = v0 ? p0[r] - slope * (float)d0 : NEGBIG; p1[r] = v1 ? p1[r] - slope * (float)d1 : NEGBIG;
            }
            softmax_pv(p0, p1, lds + j * 16384 + 8192, o0, o1, m, l, lane, hi);
        }
        float lt = l + __shfl_xor(l, 32);
        lt += exp2f(p.swa_sinks[hq] * LOG2E - m);
        store_o(ATT + (size_t)(rowb + qw) * DM + 512 + hq * 64, DM, o0, o1, 1.f / lt, r32, hi);
    }
}
__device__ __forceinline__ void phase_swa(const Params& p, LAS unsigned char* lds) {
    for (int u = blockIdx.x; u < BATCH * 2 * 64; u += gridDim.x) { const int bk = u & 7; swa_unit(p, lds, bk >> 1, bk & 1, u >> 3); }
}

__device__ __forceinline__ void phase6(const Params& p) {
    const int tid_ = fresh_tid(); const int lane = tid_ & 63, wid = tid_ >> 6;
    const int gw = blockIdx.x * NWAVES + wid, ngw = gridDim.x * NWAVES;
    const float* mod = (const float*)(p.ws + WS_MOD);
    const bf16_t* Y1 = (const bf16_t*)(p.ws + WS_PROJ); bf16_t* H = (bf16_t*)(p.ws + WS_H);
    float* X1 = (float*)(p.ws + WS_X1); float* HMAX = (float*)(p.ws + WS_HMAX);
    float gpm[16], gpf[16]; ld16(p.g_post_mix, lane, gpm); ld16(p.g_pre_ffn, lane, gpf);
    for (int t0 = gw * 16; t0 < T; t0 += ngw * 16) {
        const int b = t0 / SEQ;
        float G1[16], A2[16], sh[16];
        { float gt[16], sc[16]; ld16(mod + b * NMOD + 2 * DM, lane, gt); ld16(mod + b * NMOD + 3 * DM, lane, sh); ld16(mod + b * NMOD + 4 * DM, lane, sc);
#pragma unroll
          for (int i = 0; i < 16; ++i) { G1[i] = gt[i] * gpm[i]; A2[i] = gpf[i] * (1.f + sc[i]); } }
        float yn[16], xn[16]; ld16_bf16(Y1 + (size_t)t0 * DM, lane, yn); ld16(p.x + (size_t)t0 * DM, lane, xn);
#pragma unroll 1
        for (int r = 0; r < 16; ++r) {
            const int t = t0 + r;
            float y[16], xv[16];
#pragma unroll
            for (int i = 0; i < 16; ++i) { y[i] = yn[i]; xv[i] = xn[i]; }
            if (r + 1 < 16) { ld16_bf16(Y1 + (size_t)(t + 1) * DM, lane, yn); ld16(p.x + (size_t)(t + 1) * DM, lane, xn); }
            float ss = 0.f;
#pragma unroll
            for (int i = 0; i < 16; ++i) ss += y[i] * y[i];
            const float rstd = rsqrtf(wave_sum_dpp(ss) * (1.f / DM) + RMS_EPS);
            float x1[16]; float s2 = 0.f;
#pragma unroll
            for (int i = 0; i < 16; ++i) { x1[i] = xv[i] + G1[i] * (y[i] * rstd); s2 += x1[i] * x1[i]; }
            st16_bf16((bf16_t*)(p.ws + WS_X1) + (size_t)t * DM, lane, x1);
            const float rstd2 = rsqrtf(wave_sum_dpp(s2) * (1.f / DM) + RMS_EPS);
            float h[16]; float hm = 0.f;
#pragma unroll
            for (int i = 0; i < 16; ++i) { h[i] = x1[i] * rstd2 * A2[i] + sh[i]; hm = fmaxf(hm, fabsf(__uint_as_float(cvtpk(h[i], 0.f) << 16))); }
            st16_bf16(H + (size_t)t * DM, lane, h);
#pragma unroll
            for (int o = 1; o < 64; o <<= 1) hm = fmaxf(hm, __shfl_xor(hm, o));
            if (lane == 0) HMAX[t] = hm;
        }
    }
}

template <int N> __device__ __forceinline__ void bitonic_sort_desc(float (&v)[N]) {
#pragma unroll
    for (int k = 2; k <= N; k <<= 1)
#pragma unroll
        for (int j = k >> 1; j > 0; j >>= 1)
#pragma unroll
            for (int i = 0; i < N; ++i) { const int x = i ^ j; if (x > i) { const bool up = ((i & k) == 0); const float a = v[i], b = v[x]; const float mx = vmaxf(a, b), mn = vminf(a, b); v[i] = up ? mx : mn; v[x] = up ? mn : mx; } }
}
__device__ __forceinline__ void bitonic_merge16_desc(float (&v)[16]) {
#pragma unroll
    for (int j = 8; j > 0; j >>= 1)
#pragma unroll
        for (int i = 0; i < 16; ++i) { const int x = i ^ j; if (x > i) { const float a = v[i], b = v[x]; v[i] = vmaxf(a, b); v[x] = vminf(a, b); } }
}
__device__ __forceinline__ void merge_partner(float (&a)[16], int xm) {
    float c[16];
#pragma unroll
    for (int i = 0; i < 16; ++i) c[i] = vmaxf(a[i], __shfl_xor(a[15 - i], xm));
    bitonic_merge16_desc(c);
#pragma unroll
    for (int i = 0; i < 16; ++i) a[i] = c[i];
}
__device__ __forceinline__ unsigned sel4(unsigned w0, unsigned w1, unsigned w2, unsigned w3, unsigned a) {
    const unsigned lo = (a & 4u) ? w1 : w0, hi2 = (a & 4u) ? w3 : w2; const unsigned w = (a & 8u) ? hi2 : lo; return (w >> (8u * (a & 3u))) & 0x7fu;
}
__device__ __forceinline__ void p8_stage(LAS unsigned char* buf, const bf16_t* SK, int g, int wid, int lane) {
#pragma unroll
    for (int j = 0; j < 4; ++j) { const int pc = wid * 4 + j, row = 4 * pc + (lane >> 4), pos = lane & 15;
        const unsigned char* src = (const unsigned char*)SK + (size_t)g * 32768 + row * 256 + ((pos ^ (row & 15)) << 4);
        __builtin_amdgcn_global_load_lds((const unsigned*)src, (LAS unsigned*)(buf + pc * 1024), 16, 0, 0); }
}
__device__ __forceinline__ void phase8_block(const Params& p, LAS unsigned char* lds, int t0, int wid, int lane) {
    const int fr = lane & 15, fq = lane >> 4;
    const bf16_t* Q2 = (const bf16_t*)(p.ws + WS_PROJ); const bf16_t* SK = (const bf16_t*)(p.ws + WS_SK);
    int* EIDX = (int*)(p.ws + WS_EIDX); float* GATE = (float*)(p.ws + WS_GATE);
    float keep[2][2][16];
#pragma unroll
    for (int a_ = 0; a_ < 2; ++a_)
#pragma unroll
        for (int b_ = 0; b_ < 2; ++b_)
#pragma unroll
            for (int i_ = 0; i_ < 16; ++i_) keep[a_][b_][i_] = 0.f;
    const bf16_t* qrow = Q2 + (size_t)(t0 + fr) * 2048 + 8 * fq;
    bf16x8 bqn[4];
#pragma unroll
    for (int s = 0; s < 4; ++s) bqn[s] = *(const bf16x8*)(qrow + 32 * s);
    __syncthreads();
    p8_stage(lds, SK, 0, wid, lane);
#pragma unroll 1
    for (int hp = 0; hp < 4; ++hp) {
#pragma unroll
        for (int hh = 0; hh < 2; ++hh) {
#pragma unroll
            for (int pp = 0; pp < 2; ++pp) {
                const int grp = (2 * hp + hh) * 2 + pp;
                bf16x8 bq[4];
#pragma unroll
                for (int s = 0; s < 4; ++s) bq[s] = bqn[s];
                __syncthreads();
                if (grp + 1 < 16) { p8_stage(lds + ((grp + 1) & 1) * 32768, SK, grp + 1, wid, lane);
#pragma unroll
                    for (int s = 0; s < 4; ++s) bqn[s] = *(const bf16x8*)(qrow + (grp + 1) * 128 + 32 * s); }
                const LAS unsigned char* kb_ = lds + (grp & 1) * 32768 + fr * 256;
                float v[32];
#pragma unroll
                for (int mt = 0; mt < 8; ++mt) {
                    f32x4 acc = (f32x4){0.f, 0.f, 0.f, 0.f};
#pragma unroll
                    for (int s = 0; s < 4; ++s) { const bf16x8 a = *(const LAS bf16x8*)(kb_ + mt * 4096 + (((4 * s + fq) ^ fr) << 4)); acc = __builtin_amdgcn_mfma_f32_16x16x32_bf16(a, bq[s], acc, 0, 0, 0); }
                    unsigned f4 = 4u * (unsigned)fq; asm volatile("" : "+v"(f4));
#pragma unroll
                    for (int i = 0; i < 4; ++i) v[mt * 4 + i] = __uint_as_float(((__float_as_uint(acc[i]) & ~127u) | f4) | (unsigned)(16 * mt + i));
                }
                bitonic_sort_desc<32>(v);
                float a16[16];
#pragma unroll
                for (int i = 0; i < 16; ++i) a16[i] = v[i];
                merge_partner(a16, 16); merge_partner(a16, 32);
                const bool mine = (fq == hp);
#pragma unroll
                for (int i = 0; i < 16; ++i) keep[hh][pp][i] = mine ? a16[i] : keep[hh][pp][i];
            }
        }
    }
#pragma unroll
    for (int hh = 0; hh < 2; ++hh) {
        const float (&L1)[16] = keep[hh][0]; const float (&L2)[16] = keep[hh][1];
#define P8_CAND(a, b) __uint_as_float((__float_as_uint(L1[a] + L2[b]) & ~255u) | (unsigned)((a) * 16 + (b)))
        float R[16], Bl[16], Cl[16];
#pragma unroll
        for (int bb = 0; bb < 16; ++bb) R[bb] = P8_CAND(0, bb);
#pragma unroll
        for (int i = 0; i < 8; ++i) { Bl[i] = P8_CAND(1, i); Bl[8 + i] = P8_CAND(15 - i, 0); }
        bitonic_merge16_desc(Bl);
        Cl[0] = P8_CAND(2, 0); Cl[1] = P8_CAND(2, 1); Cl[2] = P8_CAND(2, 2); Cl[3] = P8_CAND(2, 3); Cl[4] = P8_CAND(2, 4);
        Cl[5] = P8_CAND(3, 0); Cl[6] = P8_CAND(3, 1); Cl[7] = P8_CAND(3, 2); Cl[8] = P8_CAND(3, 3);
        Cl[9] = P8_CAND(4, 0); Cl[10] = P8_CAND(4, 1); Cl[11] = P8_CAND(4, 2);
        Cl[12] = P8_CAND(5, 0); Cl[13] = P8_CAND(5, 1); Cl[14] = P8_CAND(6, 0); Cl[15] = P8_CAND(6, 1);
        bitonic_sort_desc<16>(Cl);
        { float c[16];
#pragma unroll
          for (int i = 0; i < 16; ++i) c[i] = vmaxf(R[i], Bl[15 - i]);
          bitonic_merge16_desc(c);
#pragma unroll
          for (int i = 0; i < 16; ++i) c[i] = vmaxf(c[i], Cl[15 - i]);
          bitonic_merge16_desc(c);
          c[15] = vmaxf(c[15], P8_CAND(7, 0)); c[14] = vmaxf(c[14], P8_CAND(7, 1));
          bitonic_merge16_desc(c);
#pragma unroll
          for (int i = 0; i < 16; ++i) R[i] = c[i]; }
#undef P8_CAND
        unsigned pk1[4], pk2[4];
#pragma unroll
        for (int w = 0; w < 4; ++w) {
            pk1[w] = (__float_as_uint(L1[4 * w]) & 127u) | ((__float_as_uint(L1[4 * w + 1]) & 127u) << 8) | ((__float_as_uint(L1[4 * w + 2]) & 127u) << 16) | ((__float_as_uint(L1[4 * w + 3]) & 127u) << 24);
            pk2[w] = (__float_as_uint(L2[4 * w]) & 127u) | ((__float_as_uint(L2[4 * w + 1]) & 127u) << 8) | ((__float_as_uint(L2[4 * w + 2]) & 127u) << 16) | ((__float_as_uint(L2[4 * w + 3]) & 127u) << 24);
        }
        float mx = R[0];
#pragma unroll
        for (int i = 1; i < 16; ++i) mx = fmaxf(mx, R[i]);
        float e[16]; float se = 0.f;
#pragma unroll
        for (int i = 0; i < 16; ++i) { e[i] = __expf(R[i] - mx); se += e[i]; }
        const float inv = 1.f / se;
        int ex[16];
#pragma unroll
        for (int i = 0; i < 16; ++i) { const unsigned bits = __float_as_uint(R[i]); const unsigned a = (bits >> 4) & 15u, bb = bits & 15u;
            ex[i] = (int)(sel4(pk1[0], pk1[1], pk1[2], pk1[3], a) * 128u + sel4(pk2[0], pk2[1], pk2[2], pk2[3], bb)); e[i] *= inv; }
        const int head = 2 * fq + hh;
        int* ep = EIDX + (size_t)(t0 + fr) * 128 + head * 16; float* gp = GATE + (size_t)(t0 + fr) * 128 + head * 16;
#pragma unroll
        for (int i = 0; i < 16; i += 4) {
            int pk_[4];
#pragma unroll
            for (int q = 0; q < 4; ++q) pk_[q] = (int)((unsigned)ex[i + q] | ((cvtpk(e[i + q], 0.f) & 0xffffu) << 16));
            *(int4*)(ep + i) = make_int4(pk_[0], pk_[1], pk_[2], pk_[3]); }
        (void)gp;
    }
}

__device__ __forceinline__ float gelu_tanh(float x) {
    const float z = 0.7978845608028654f * (x + 0.044715f * x * x * x);
    const float e = __expf(2.f * z); const float th = 1.f - 2.f * __builtin_amdgcn_rcpf(e + 1.f);
    return 0.5f * x * (1.f + th);
}
constexpr int P9_LIST = 0, P9_ACT = 4096, P9_STAGE = 6144, P9_RING = 7168  , P9_VRING = 4096  , P9_WAVE_LDS = 20480, P9_NBATCH = 64, P9_NENT = 1024;
typedef long i64_t;
__device__ __forceinline__ unsigned pk4_fp8(float a, float b, float c, float d) { int t_ = __builtin_amdgcn_cvt_pk_fp8_f32(a, b, 0, false); t_ = __builtin_amdgcn_cvt_pk_fp8_f32(c, d, t_, true); return (unsigned)t_; }

__device__ __forceinline__ void p9_dma_third(const unsigned char* const (&rowp)[4]  , unsigned ringaddr, int t, unsigned buf) {
#pragma unroll
    for (int j = 0; j < 4; ++j) glds16(rowp[j] + 256 * t, (unsigned)__builtin_amdgcn_readfirstlane((int)(ringaddr + buf * 4096u + (unsigned)j * 1024u)));
}
__device__ __forceinline__ void p9_rowptrs(const unsigned char* (&rowp)[4], const LAS unsigned* list, const unsigned char* U6, int batch, int lane) {
#pragma unroll
    for (int j = 0; j < 4; ++j) { const int row = 4 * j + (lane >> 4); const unsigned ent = list[batch * 16 + row];
        rowp[j] = U6 + (size_t)(ent & 0x3fffu) * 512 + 16 * ((lane & 15) ^ row); }
}
typedef int i32x8 __attribute__((ext_vector_type(8)));
template <int M> __device__ __forceinline__ void p9_mma_fp4(f32x4& acc, const LAS unsigned char* ringp, const i32x8 (&B)[8], unsigned hb0, int fr, int fq) {
    const u32x4 g = *(const LAS u32x4*)(ringp + (((hb0 + (unsigned)(M >> 2)) & 3u) << 12) + fr * 256 + ((((unsigned)(4 * (M & 3) + fq)) ^ (unsigned)fr) << 4));
    const i32x8 a = {(int)g.x, (int)g.y, (int)g.z, (int)g.w, 0, 0, 0, 0};
    acc = __builtin_amdgcn_mfma_scale_f32_16x16x128_f8f6f4(a, B[M], acc, 4  , 0  , 0, 0x7f7f7f7f, 0, 0x7f7f7f7f);
}
__device__ __forceinline__ void p9_rowptrs_q(const unsigned char* (&rowp)[2], const LAS unsigned* list, const unsigned char* U4, int batch, int lane) {
#pragma unroll
    for (int j = 0; j < 2; ++j) { const int row = 8 * j + (lane >> 3); const unsigned ent = list[batch * 16 + row];
        rowp[j] = U4 + (size_t)(ent & 0x3fffu) * 512 + 16 * ((lane & 7) ^ ((row >> 1) & 7)); }
}
__device__ __forceinline__ void p9_dma_quarter(const unsigned char* const (&rowp)[2], int q, unsigned bufaddr  ) {
#pragma unroll
    for (int j = 0; j < 2; ++j) glds16(rowp[j] + 128 * q, (unsigned)__builtin_amdgcn_readfirstlane((int)(bufaddr + (unsigned)j * 1024u)));
}
template <int M> __device__ __forceinline__ void p9_mma_q(f32x4& acc, const LAS unsigned char* bufp  , unsigned lofs  , const i32x8 (&B)[8]) {
    const u32x4 g = *(const LAS u32x4*)(bufp + lofs);
    const i32x8 a = {(int)g.x, (int)g.y, (int)g.z, (int)g.w, 0, 0, 0, 0};
    acc = __builtin_amdgcn_mfma_scale_f32_16x16x128_f8f6f4(a, B[M], acc, 4  , 0  , 0, 0x7f7f7f7f, 0, 0x7f7f7f7f);
}
__device__ __forceinline__ void p9_extract(const f32x4& acc, const LAS unsigned* list, LAS float* stage, LAS bf16_t* actl, int n0, int fr, int fq) {
    *(LAS f32x4*)(stage + fr * 16 + 4 * fq) = acc;
    const unsigned ent = list[n0 + fr]; const unsigned s_ = (ent >> 14) & 7u, idx = (ent >> 17) & 127u;
    const float val = stage[(2 * s_) * 16 + fr];
    if (fq == 0) actl[s_ * 128 + idx] = (bf16_t)(cvtpk(val, 0.f) & 0xffffu);
}

__device__ __forceinline__ void phase9_pass(const Params& p, LAS unsigned char* wl  , int tk0  , int lane) {
    const bf16_t* H = (const bf16_t*)(p.ws + WS_H);
    const unsigned char* U8 = p.ws + WS_U8; const unsigned char* V8 = p.ws + WS_V8;
    const float* SU = (const float*)(p.ws + WS_SU); const float* SV = (const float*)(p.ws + WS_SV);
    const int* EIDX = (const int*)(p.ws + WS_EIDX); const float* GATE = (const float*)(p.ws + WS_GATE);
    const float* HMAX = (const float*)(p.ws + WS_HMAX);
    const float* mod = (const float*)(p.ws + WS_MOD);
    LAS unsigned* list = (LAS unsigned*)(wl + P9_LIST);
    LAS bf16_t* actl = (LAS bf16_t*)(wl + P9_ACT);
    LAS float* stage = (LAS float*)(wl + P9_STAGE);
    LAS unsigned char* ringp = wl + P9_RING;
    LAS unsigned* cnt = (LAS unsigned*)ringp;
    LAS unsigned* off = cnt + 64;
    const int fr = lane & 15, fq = lane >> 4;
    cnt[lane] = 0u;
    unsigned offreg;
    {
        unsigned ee[16], rk[16];
#pragma unroll
        for (int i = 0; i < 16; ++i) ee[i] = (unsigned)EIDX[(size_t)(tk0 + (i >> 1)) * 128 + 64 * (i & 1) + lane] & 0x3fffu;
#pragma unroll
        for (int i = 0; i < 16; ++i) rk[i] = atomicAdd((unsigned*)&cnt[(ee[i] >> 11) * 8u + (unsigned)(i >> 1)], 1u);
        { const unsigned c = cnt[lane]; unsigned inc = c;
#pragma unroll
          for (int o = 1; o < 64; o <<= 1) { const unsigned n_ = __shfl_up(inc, o); if (lane >= o) inc += n_; }
          offreg = inc - c; off[lane] = offreg; }
#pragma unroll
        for (int i = 0; i < 16; ++i) list[off[(ee[i] >> 11) * 8u + (unsigned)(i >> 1)] + rk[i]] = ee[i] | ((unsigned)(i >> 1) << 14) | ((unsigned)(64 * (i & 1) + lane) << 17);
    }
    asm volatile("" ::: "memory");
    i32x8 B[8];
    {
        const int slot = fr >> 1;
        const bf16_t* hrow = H + (size_t)(tk0 + slot) * DM + 16 * fq;
        const float mx = HMAX[tk0 + slot];
        const float hs = mx > 0.f ? 224.f / mx : 1.f;
        const bool lo_part = (fr & 1) != 0;
#pragma unroll
        for (int mg = 0; mg < 4; ++mg) {
            u32x4 hv[2][4];
#pragma unroll
            for (int mm = 0; mm < 2; ++mm)
#pragma unroll
                for (int c = 0; c < 4; ++c) hv[mm][c] = *(const u32x4*)(hrow + 128 * (2 * mg + mm) + 64 * (c >> 1) + 8 * (c & 1));
            asm volatile("" ::: "memory");
#pragma unroll
            for (int mm = 0; mm < 2; ++mm) {
                i32x8 w;
#pragma unroll
                for (int c = 0; c < 4; ++c) { const u32x4 a = hv[mm][c];
                    w[2 * c] = (int)pk4_fp8(bflo(a.x) * hs, bfhi(a.x) * hs, bflo(a.y) * hs, bfhi(a.y) * hs);
                    w[2 * c + 1] = (int)pk4_fp8(bflo(a.z) * hs, bfhi(a.z) * hs, bflo(a.w) * hs, bfhi(a.w) * hs); }
                const i32x8 wz = {0, 0, 0, 0, 0, 0, 0, 0};
                B[2 * mg + mm] = lo_part ? wz : w;
            }
        }
    }
    {
        __builtin_amdgcn_s_waitcnt(0);
        const unsigned ringaddr = (unsigned)__builtin_amdgcn_readfirstlane((int)(unsigned)(uintptr_t)ringp);
        const unsigned lofs0 = (unsigned)(fr * 128 + (((unsigned)fq ^ (unsigned)((fr >> 1) & 7)) << 4)), lofs1 = (unsigned)(fr * 128 + (((unsigned)(4 + fq) ^ (unsigned)((fr >> 1) & 7)) << 4));
        const unsigned char* row1[2]; const unsigned char* row2[2];
        p9_rowptrs_q(row2, list, U8, 0, lane); p9_rowptrs_q(row1, list, U8, 1, lane);
        p9_dma_quarter(row2, 0, ringaddr); p9_dma_quarter(row2, 1, ringaddr + 2048u); p9_dma_quarter(row2, 2, ringaddr + 4096u); p9_dma_quarter(row2, 3, ringaddr + 6144u); p9_dma_quarter(row1, 0, ringaddr + 8192u);
        unsigned rb = 0u, wb = 5u * 2048u;
#define P9_UQ(Q, ROWS, QN) do { \
            asm volatile("s_waitcnt vmcnt(8)" ::: "memory"); \
            p9_mma_q<2 * (Q)>(acc, ringp + rb, lofs0, B); p9_mma_q<2 * (Q) + 1>(acc, ringp + rb, lofs1, B); \
            asm volatile("s_waitcnt lgkmcnt(0)" ::: "memory"); \
            p9_dma_quarter(ROWS, (QN), ringaddr + wb); \
            rb = rb + 2048u == 6u * 2048u ? 0u : rb + 2048u; wb = wb + 2048u == 6u * 2048u ? 0u : wb + 2048u; \
        } while (0)
#pragma unroll 1
        for (int b = 0; b < P9_NBATCH; ++b) {
            f32x4 acc = (f32x4){0.f, 0.f, 0.f, 0.f};
            p9_rowptrs_q(row2, list, U8, b + 2 < P9_NBATCH ? b + 2 : P9_NBATCH - 1, lane);
            P9_UQ(0, row1, 1); P9_UQ(1, row1, 2); P9_UQ(2, row1, 3); P9_UQ(3, row2, 0);
            p9_extract(acc, list, stage, actl, 16 * b, fr, fq);
            row1[0] = row2[0]; row1[1] = row2[1];
        }
#undef P9_UQ
        asm volatile("s_waitcnt vmcnt(0)" ::: "memory");
    }
    float sainv[8];
    {
        float av[16]; unsigned en[16]; float amax[8] = {0.f, 0.f, 0.f, 0.f, 0.f, 0.f, 0.f, 0.f};
#pragma unroll
        for (int k = 0; k < 16; ++k) {
            const unsigned ent = list[k * 64 + lane]; const unsigned e = ent & 0x3fffu, s_ = (ent >> 14) & 7u, idx = (ent >> 17) & 127u;
            const float d = __uint_as_float((unsigned)actl[s_ * 128 + idx] << 16);
            const float g = __uint_as_float((unsigned)EIDX[(size_t)(tk0 + s_) * 128 + idx] & 0xffff0000u), hi_ = HMAX[tk0 + s_] * (1.f / 224.f);
            av[k] = gelu_tanh(d * (SU[e] * hi_)) * (g * SV[e]); en[k] = ent;
#pragma unroll
            for (int q = 0; q < 8; ++q) amax[q] = fmaxf(amax[q], s_ == (unsigned)q ? fabsf(av[k]) : 0.f);
        }
        float sa[8];
#pragma unroll
        for (int q = 0; q < 8; ++q) { float m = amax[q];
#pragma unroll
            for (int o = 1; o < 64; o <<= 1) m = fmaxf(m, __shfl_xor(m, o));
            sa[q] = m > 0.f ? 224.f / m : 1.f; sainv[q] = m > 0.f ? m * (1.f / 224.f) : 1.f; }
        asm volatile("s_waitcnt lgkmcnt(0)" ::: "memory");
#pragma unroll
        for (int k = 0; k < 16; ++k) { const unsigned s_ = (en[k] >> 14) & 7u;
            float sc = sa[0];
#pragma unroll
            for (int q = 1; q < 8; ++q) sc = s_ == (unsigned)q ? sa[q] : sc;
            const unsigned b8 = (unsigned)__builtin_amdgcn_cvt_pk_fp8_f32(av[k] * sc, 0.f, 0, false) & 0xffu;
            list[k * 64 + lane] = (en[k] & 0x00ffffffu) | (b8 << 24); }
    }
    {
        LAS unsigned char* vring = wl + P9_VRING;
        f32x16 y[8];
#pragma unroll
        for (int s_ = 0; s_ < 8; ++s_)
#pragma unroll
            for (int r = 0; r < 16; ++r) y[s_][r] = 0.f;
        __builtin_amdgcn_s_waitcnt(0);
        const unsigned ringaddr = (unsigned)__builtin_amdgcn_readfirstlane((int)(unsigned)(uintptr_t)vring);
        const int j5 = lane & 31, kg = lane >> 5;
        const unsigned lo16 = 16u * (unsigned)j5;
        unsigned am[4];
#pragma unroll
        for (int d = 0; d < 4; ++d) am[d] = (kg == (j5 >> 4) && d == ((j5 & 15) >> 2)) ? (0xffu << (8 * (j5 & 3))) : 0u;
#define P9_VISSUE2E(m, ENT) do { const unsigned off_ = (((ENT) & 0x3fffu) << 9) | lo16; \
            const unsigned dst_ = (unsigned)__builtin_amdgcn_readfirstlane((int)(ringaddr + ((((unsigned)(m)) & 31u) << 9))); \
            asm volatile("s_mov_b32 m0, %2\n\ts_nop 0\n\tglobal_load_lds_dwordx4 %0, %1" :: "v"(off_), "s"(V8), "s"(dst_) : "memory", "m0"); } while (0)
#pragma unroll 1
        for (int m_ = 0; m_ < 32; m_ += 2) P9_VISSUE2E(m_, list[m_ + kg]);
        int n = 0, iss = 32;
        asm volatile("s_waitcnt vmcnt(14)" ::: "memory");
        u32x4 bq = *(const LAS u32x4*)(vring + (((unsigned)kg) << 9) + lo16);
        unsigned a0q = list[0], a1q = list[1], enq = list[32 + kg];
#define P9_VPAIR(S, TWO) do { \
            asm volatile("s_waitcnt lgkmcnt(0)" ::: "memory");        \
            const int nn_ = n + ((TWO) ? 2 : 1); const bool doi_ = iss <= nn_ + 30; \
            const unsigned a0_ = __builtin_amdgcn_perm(a0q, a0q, 0x03030303u), a1_ = (TWO) ? __builtin_amdgcn_perm(a1q, a1q, 0x03030303u) : 0u;     \
            const i32x8 am_ = {(int)(a0_ & am[0]), (int)(a0_ & am[1]), (int)(a0_ & am[2]), (int)(a0_ & am[3]), (int)(a1_ & am[0]), (int)(a1_ & am[1]), (int)(a1_ & am[2]), (int)(a1_ & am[3])}; \
            const i32x8 bm_ = {(int)bq.x, (int)bq.y, (int)bq.z, (int)bq.w, 0, 0, 0, 0}; \
            y[S] = __builtin_amdgcn_mfma_scale_f32_32x32x64_f8f6f4(am_, bm_, y[S], 0  , 4  , 0, 0x7f7f7f7f, 0, 0x7f7f7f7f); \
            if (doi_) { P9_VISSUE2E(iss, enq); iss += 2; } \
            asm volatile("s_waitcnt vmcnt(13)" ::: "memory"); \
            bq = *(const LAS u32x4*)(vring + ((((unsigned)(nn_ + kg)) & 31u) << 9) + lo16); \
            a0q = list[nn_]; a1q = list[nn_ + 1]; \
            { const int mi_ = iss + kg; enq = list[mi_ < P9_NENT ? mi_ : P9_NENT - 1]; } \
        } while (0)
#define P9_VSEG(S, END) do { const int end_ = (END); \
            _Pragma("unroll 1") for (; n + 1 < end_; n += 2) P9_VPAIR(S, true); \
            if (n < end_) { P9_VPAIR(S, false); ++n; } } while (0)
#pragma unroll 1
        for (int b = 0; b < 8; ++b) {
            P9_VSEG(0, __builtin_amdgcn_readlane((int)offreg, 8 * b + 1));
            P9_VSEG(1, __builtin_amdgcn_readlane((int)offreg, 8 * b + 2));
            P9_VSEG(2, __builtin_amdgcn_readlane((int)offreg, 8 * b + 3));
            P9_VSEG(3, __builtin_amdgcn_readlane((int)offreg, 8 * b + 4));
            P9_VSEG(4, __builtin_amdgcn_readlane((int)offreg, 8 * b + 5));
            P9_VSEG(5, __builtin_amdgcn_readlane((int)offreg, 8 * b + 6));
            P9_VSEG(6, __builtin_amdgcn_readlane((int)offreg, 8 * b + 7));
            P9_VSEG(7, (b < 7) ? __builtin_amdgcn_readlane((int)offreg, (8 * b + 8) & 63) : P9_NENT);
        }
        asm volatile("s_waitcnt vmcnt(0)" ::: "memory");
        const int bsel = tk0 / SEQ; const int eo = 32 * j5 + 4 * kg;
        f32x4 gtg[4];
#pragma unroll
        for (int u = 0; u < 4; ++u) gtg[u] = *(const f32x4*)(mod + bsel * NMOD + 5 * DM + 8 * u + eo) * *(const f32x4*)(p.g_post_ffn + 8 * u + eo);
#pragma unroll
        for (int s_ = 0; s_ < 8; ++s_) {
            const int t_ = tk0 + s_;
            f32x4 yy[4];
            float ss = 0.f;
#pragma unroll
            for (int u = 0; u < 4; ++u) { yy[u] = (f32x4){y[s_][4 * u], y[s_][4 * u + 1], y[s_][4 * u + 2], y[s_][4 * u + 3]} * sainv[s_]; ss += yy[u][0] * yy[u][0] + yy[u][1] * yy[u][1] + yy[u][2] * yy[u][2] + yy[u][3] * yy[u][3]; }
            const float rstd = rsqrtf(wave_sum_dpp(ss) * (1.f / DM) + RMS_EPS);
            float* orow = p.out + (size_t)t_ * DM + eo; const bf16_t* xrow = (const bf16_t*)(p.ws + WS_X1) + (size_t)t_ * DM + eo;
#pragma unroll
            for (int u = 0; u < 4; ++u) { const u32x2 xb = *(const u32x2*)(xrow + 8 * u); const f32x4 x1 = {bflo(xb.x), bfhi(xb.x), bflo(xb.y), bfhi(xb.y)}; *(f32x4*)(orow + 8 * u) = x1 + gtg[u] * (yy[u] * rstd); }
        }
        asm volatile("s_waitcnt lgkmcnt(0)" ::: "memory");
    }
}

#define XB_TMO      128
#define XB_XCNT(j)  (256  + 64 * (j))
#define XB_XSUB(j)  (1280 + 64 * (j))
#define XB_XGEN(j)  (2304 + 64 * (j))
#define XB_TOP      3328
#define XB_TOPGEN   3392
#define XCD_BAR_WORDS 3456
#define XB_SPIN_CAP (1u << 18)

__device__ __forceinline__ unsigned xb_ld(unsigned* p)              { return __hip_atomic_load(p, __ATOMIC_RELAXED, __HIP_MEMORY_SCOPE_AGENT); }
__device__ __forceinline__ unsigned xb_add(unsigned* p, unsigned v) { return __hip_atomic_fetch_add(p, v, __ATOMIC_RELAXED, __HIP_MEMORY_SCOPE_AGENT); }
__device__ __forceinline__ unsigned xb_xcc_id() { return (unsigned)__builtin_amdgcn_s_getreg((3 << 11) | 20) & 0xFu; }
#define XB_SPIN(cond, bar) do { unsigned _sp = 0; while (cond) { __builtin_amdgcn_s_sleep(1); \
    if ((++_sp & 255u) == 0u) { if (xb_ld(&(bar)[XB_TMO])) break; if (_sp > XB_SPIN_CAP) { atomicAdd(&(bar)[XB_TMO], 1u); break; } } } } while (0)

struct XcdBarrier {
    unsigned* bar; unsigned x;
    volatile LAS unsigned* st;
};

__device__ __forceinline__ XcdBarrier xcd_barrier_post(unsigned* bar, volatile LAS unsigned* st) {
    XcdBarrier b; b.bar = bar; b.x = xb_xcc_id(); b.st = st;
    if (threadIdx.x == 0) (void)xb_add(&bar[XB_XCNT(b.x)], 1u);
    return b;
}
__device__ __forceinline__ void xcd_barrier_complete(unsigned* bar, unsigned x, unsigned& nloc, unsigned& nx) {
    const unsigned G = gridDim.x * gridDim.y * gridDim.z;
    unsigned sum, cnt, mine, sp = 0u;
    for (;;) {
        sum = 0u; cnt = 0u; mine = 0u;
#pragma unroll
        for (unsigned j = 0; j < 16; ++j) { const unsigned c = xb_ld(&bar[XB_XCNT(j)]); sum += c; cnt += (c > 0u) ? 1u : 0u; mine = (j == x) ? c : mine; }
        if (sum == G) break;
        __builtin_amdgcn_s_sleep(1);
        if ((++sp & 255u) == 0u) { if (xb_ld(&bar[XB_TMO])) break; if (sp > XB_SPIN_CAP) { atomicAdd(&bar[XB_TMO], 1u); break; } }
    }
    nloc = mine > 0u ? mine : 1u; nx = cnt > 0u ? cnt : 1u;
}

__device__ __forceinline__ void xcd_barrier(const XcdBarrier& b) {
    asm volatile("s_waitcnt vmcnt(0)" ::: "memory");
    __syncthreads();
    if (threadIdx.x == 0) {
        unsigned* bar = b.bar;
        __builtin_amdgcn_s_waitcnt(0);
        unsigned nloc = b.st[0], nx = b.st[1];
        if (nloc == 0u) { xcd_barrier_complete(bar, b.x, nloc, nx); b.st[0] = nloc; b.st[1] = nx; }
        const unsigned old = xb_add(&bar[XB_XSUB(b.x)], 1u);
        const unsigned gen = old / nloc;
        if (old + 1u == (gen + 1u) * nloc) {
            __builtin_amdgcn_fence(__ATOMIC_RELEASE, "agent");
            asm volatile("s_waitcnt vmcnt(0)" ::: "memory");
            const unsigned og = xb_add(&bar[XB_TOP], 1u);
            const unsigned tg = og / nx;
            if (og + 1u == (tg + 1u) * nx) xb_add(&bar[XB_TOPGEN], 1u);
            else XB_SPIN(xb_ld(&bar[XB_TOPGEN]) == tg, bar);
            __builtin_amdgcn_fence(__ATOMIC_ACQUIRE, "agent");
            xb_add(&bar[XB_XGEN(b.x)], 1u);
            asm volatile("s_waitcnt vmcnt(0)" ::: "memory");
        } else {
            XB_SPIN(xb_ld(&bar[XB_XGEN(b.x)]) == gen, bar);
            __builtin_amdgcn_fence(__ATOMIC_ACQUIRE, "agent");
            asm volatile("s_waitcnt vmcnt(0)" ::: "memory");
        }
    }
    __syncthreads();
}


__global__ void __launch_bounds__(NTHREADS, 2) fwd_kernel(Params p) {
    extern __shared__ __attribute__((aligned(16))) unsigned char lds_raw[];
    LAS unsigned char* lds = (LAS unsigned char*)lds_raw;
    volatile LAS unsigned* bst = (volatile LAS unsigned*)(lds + LDS_BYTES - 16);
    if (threadIdx.x < 4) bst[threadIdx.x] = 0u;
    __syncthreads();
    const XcdBarrier xbar = xcd_barrier_post((unsigned*)(p.ws + WS_BAR), bst);
#define GRID_BAR() xcd_barrier(xbar)

    REPEAT(1, phase0(p, lds));
    GRID_BAR();
    REPEAT(2, phase1(p, lds));
    GRID_BAR();
    scan_kb(p, lds);
    REPEAT(3, {
        pg8::Gemm g{(const bf16_t*)(p.ws + WS_H), (const bf16_t*)(p.ws + WS_WTIN), T, NPROJ, DM / 2, p.ws + WS_HMAX, p.ws + WS_CMAX + 12288};
        pg8::StaticOrder S; S.init(T, NPROJ, gridDim.x, blockIdx.x);
        pg8::EpiBf16 E{(bf16_t*)(p.ws + WS_PROJ), NPROJ, 0xC3u, C2};
        pg8::gemm_phase<pg8::EpiBf16, pg8::StaticOrder, true>(lds, g, S, E);
    });
    GRID_BAR();
    REPEAT(4, { fox_prepass(p); phase_swa(p, lds); });
    GRID_BAR();
    REPEAT(5, phase_fox(p, lds));
    GRID_BAR();
    REPEAT(6, {
        pg8::Gemm g{(const bf16_t*)(p.ws + WS_ATT), (const bf16_t*)(p.ws + WS_WTOUT), T, DM, DM, nullptr, nullptr};
        pg8::StaticOrder S; S.init(T, DM, gridDim.x, blockIdx.x);
        pg8::EpiBf16 E{(bf16_t*)(p.ws + WS_PROJ), DM, 0u, 1.f};
        pg8::gemm_phase<pg8::EpiBf16, pg8::StaticOrder>(lds, g, S, E);
    });
    GRID_BAR();
    REPEAT(7, phase6(p));
    GRID_BAR();
    REPEAT(8, {
        pg8::Gemm g{(const bf16_t*)(p.ws + WS_H), (const bf16_t*)(p.ws + WS_WTQ), T, 2048, DM, nullptr, nullptr};
        pg8::StaticOrder S; S.init(T, 2048, gridDim.x, blockIdx.x);
        pg8::EpiBf16 E{(bf16_t*)(p.ws + WS_PROJ), 2048, 0u, 1.f};
        pg8::gemm_phase<pg8::EpiBf16, pg8::StaticOrder>(lds, g, S, E);
    });
    GRID_BAR();
    for (int tb = blockIdx.x * 128; tb < T; tb += gridDim.x * 128) {
        REPEAT(9, { const int t8 = fresh_tid(); phase8_block(p, lds, tb + 16 * (t8 >> 6), __builtin_amdgcn_readfirstlane(t8 >> 6), t8 & 63); });
        __builtin_amdgcn_fence(__ATOMIC_RELEASE, "workgroup");
        asm volatile("s_waitcnt vmcnt(0)" ::: "memory");
        __builtin_amdgcn_fence(__ATOMIC_ACQUIRE, "workgroup");
        __syncthreads();
#pragma unroll 1
        for (int i = 0; i < 2; ++i) { const int t9 = fresh_tid(); phase9_pass(p, lds + (t9 >> 6) * P9_WAVE_LDS, tb + 16 * (t9 >> 6) + 8 * i, t9 & 63); }
    }
}

extern "C" void kernel_launch(void* const* d_in, const int* in_sizes, int n_in, void* d_out, int out_size, void* d_ws, size_t ws_size, hipStream_t stream) {
    static int grid_blocks = 0;
    if (grid_blocks == 0) {
        if (n_in != 16 || out_size != T * DM || ws_size < WS_END) { fprintf(stderr, "kernel_launch: unexpected shapes (n_in %d out %d ws %zu)\n", n_in, out_size, ws_size); grid_blocks = -1; return; }
        int dev = 0, cus = 0, per_cu = 0;
        (void)hipGetDevice(&dev);
        (void)hipDeviceGetAttribute(&cus, hipDeviceAttributeMultiprocessorCount, dev);
        (void)hipFuncSetAttribute((const void*)fwd_kernel, hipFuncAttributeMaxDynamicSharedMemorySize, LDS_BYTES);
        (void)hipOccupancyMaxActiveBlocksPerMultiprocessor(&per_cu, (const void*)fwd_kernel, NTHREADS, LDS_BYTES);
        if (per_cu < 1) { fprintf(stderr, "kernel_launch: occupancy query says %d blocks per CU\n", per_cu); per_cu = 1; }
        grid_blocks = cus;
        fprintf(stderr, "kernel_launch: grid %d (cus %d, per_cu %d)\n", grid_blocks, cus, per_cu);
    }
    if (grid_blocks < 0) return;
    Params p{};
    p.x = (const float*)d_in[0]; p.c = (const float*)d_in[1]; p.w_ada = (const float*)d_in[2]; p.b_ada = (const float*)d_in[3];
    p.g_pre_mix = (const float*)d_in[4]; p.g_post_mix = (const float*)d_in[5]; p.g_pre_ffn = (const float*)d_in[6]; p.g_post_ffn = (const float*)d_in[7];
    p.w_in = (const float*)d_in[8]; p.b_fgate = (const float*)d_in[9]; p.swa_sinks = (const float*)d_in[10]; p.w_out = (const float*)d_in[11];
    p.w_query = (const float*)d_in[12]; p.sub_keys = (const float*)d_in[13]; p.w_u = (const float*)d_in[14]; p.w_v = (const float*)d_in[15];
    p.out = (float*)d_out; p.ws = (unsigned char*)d_ws;
    (void)hipMemsetAsync((unsigned char*)d_ws + WS_BAR, 0, 32768, stream);
    void* args[] = {&p};
    hipError_t e = hipLaunchCooperativeKernel((void*)fwd_kernel, dim3(grid_blocks), dim3(NTHREADS), args, LDS_BYTES, stream);
    if (e != hipSuccess) fprintf(stderr, "kernel_launch: cooperative launch failed: %s (grid %d)\n", hipGetErrorString(e), grid_blocks);
}
```
